# Optimizing an MI355X kernel written in HIP

```python
import jax, jax.numpy as jnp
from jax import lax
import numpy as np

D_MODEL = 1024
BATCH = 32
SEQ = 2048
DEPTH = 1

CHUNK = 64
N_META = 16
EPS = 1e-6
DN_HEADS = 8
DN_HEAD_DIM = 128
DN_QK = DN_HEADS * DN_HEAD_DIM
DN_V = DN_HEADS * DN_HEAD_DIM
CONV_WIDTH = 4
GLA_HEADS = 4
GLA_KEY_DIM = 128
GLA_VAL_DIM = 256
GLA_QK = GLA_HEADS * GLA_KEY_DIM
GLA_V = GLA_HEADS * GLA_VAL_DIM
GLA_RANK = 16
GLA_TAU = 16.0
N_GROUPS = 8
EXPERTS_PER_GROUP = 8
N_EXPERTS = N_GROUPS * EXPERTS_PER_GROUP
TOP_K = 2
D_EXPERT = 512
MOE_BLOCK = 256
IN_SPLITS = (DN_QK, DN_QK, DN_V, DN_V, DN_HEADS, DN_HEADS,
             GLA_QK, GLA_QK, GLA_V, GLA_V, GLA_RANK, D_MODEL, D_MODEL)
D_IN = sum(IN_SPLITS)

kernel_name = 'streaming_hybrid_deltanet_gla_hmoe'


def rmsnorm(x, g):
    xf = x.astype(jnp.float32)
    y = xf * lax.rsqrt(jnp.mean(jnp.square(xf), axis=-1, keepdims=True) + EPS)
    return (y * g.astype(jnp.float32)).astype(x.dtype)


def l2norm(x):
    return x * lax.rsqrt(jnp.sum(jnp.square(x), axis=-1, keepdims=True) + EPS)


def causal_conv(x, w):
    k_w, L = w.shape[0], x.shape[1]
    xp = jnp.pad(x, ((0, 0), (k_w - 1, 0), (0, 0)))
    return sum(xp[:, j:j + L] * w[j] for j in range(k_w))


def chunkify(x, pad):
    x = jnp.pad(x, ((0, 0), (pad, 0)) + ((0, 0),) * (x.ndim - 2))
    b, lp = x.shape[:2]
    x = x.reshape((b, lp // CHUNK, CHUNK) + x.shape[2:])
    return x.transpose((1, 0, 3, 2) + tuple(range(4, x.ndim)))


def unchunkify(o, pad):
    n, b, h, c, dv = o.shape
    return o.transpose(1, 0, 3, 2, 4).reshape(b, n * c, h, dv)[:, pad:]


def gated_delta_rule(q, k, v, g, beta):
    L = q.shape[1]
    pad = (-L) % CHUNK
    dk, dv = q.shape[-1], v.shape[-1]
    q, k, v = [chunkify(t, pad) for t in (q * dk ** -0.5, k, v)]
    g, beta = chunkify(g, pad), chunkify(beta, pad)
    gc = jnp.cumsum(g, axis=-1)
    causal = jnp.tril(jnp.ones((CHUNK, CHUNK), bool))
    strict = jnp.tril(jnp.ones((CHUNK, CHUNK), bool), -1)
    diff = gc[..., :, None] - gc[..., None, :]
    decay = jnp.where(causal, jnp.exp(jnp.where(causal, diff, 0.0)), 0.0)
    kk = jnp.einsum('nbhid,nbhjd->nbhij', k, k)
    a_mat = jnp.where(strict, beta[..., None] * kk * decay, 0.0) + jnp.eye(CHUNK, dtype=jnp.float32)
    rhs = jnp.concatenate([v * beta[..., None], k * (beta * jnp.exp(gc))[..., None]], axis=-1)
    sol = lax.linalg.triangular_solve(a_mat, rhs, left_side=True, lower=True, unit_diagonal=True)
    u, w = sol[..., :dv], sol[..., dv:]
    qk = jnp.where(causal, jnp.einsum('nbhid,nbhjd->nbhij', q, k) * decay, 0.0)
    q_dec = q * jnp.exp(gc)[..., None]
    g_last = gc[..., -1]
    k_dec = k * jnp.exp(g_last[..., None] - gc)[..., None]

    def step(S, xs):
        qk_c, q_c, k_c, u_c, w_c, gl = xs
        v_new = u_c - jnp.einsum('bhcd,bhde->bhce', w_c, S)
        o = jnp.einsum('bhcd,bhde->bhce', q_c, S) + jnp.einsum('bhij,bhje->bhie', qk_c, v_new)
        S = S * jnp.exp(gl)[..., None, None] + jnp.einsum('bhcd,bhce->bhde', k_c, v_new)
        return S, o

    S0 = jnp.zeros(q.shape[1:3] + (dk, dv), jnp.float32)
    _, o = lax.scan(step, S0, (qk, q_dec, k_dec, u, w, g_last))
    return unchunkify(o, pad)


def gla_attention(q, k, v, log_a):
    L = q.shape[1]
    pad = (-L) % CHUNK
    dk, dv = q.shape[-1], v.shape[-1]
    q, k, v, log_a = [chunkify(t, pad) for t in (q * dk ** -0.5, k, v, log_a)]
    b = jnp.cumsum(log_a, axis=-2)
    b_mid = b[..., CHUNK // 2 - 1:CHUNK // 2, :]
    causal = jnp.tril(jnp.ones((CHUNK, CHUNK), bool))
    att = jnp.einsum('nbhid,nbhjd->nbhij', q * jnp.exp(b - b_mid), k * jnp.exp(b_mid - b))
    o_intra = jnp.einsum('nbhij,nbhje->nbhie', jnp.where(causal, att, 0.0), v)
    q_dec = q * jnp.exp(b)
    b_last = b[..., -1, :]
    k_dec = k * jnp.exp(b_last[..., None, :] - b)

    def step(S, xs):
        q_c, k_c, v_c, bl = xs
        o = jnp.einsum('bhcd,bhde->bhce', q_c, S)
        S = S * jnp.exp(bl)[..., :, None] + jnp.einsum('bhcd,bhce->bhde', k_c, v_c)
        return S, o

    S0 = jnp.zeros(q.shape[1:3] + (dk, dv), jnp.float32)
    _, o_inter = lax.scan(step, S0, (q_dec, k_dec, v, b_last))
    return unchunkify(o_inter + o_intra, pad)


def hybrid_mixer(h, w_in, conv_dn, a_log, dt_bias, norm_head_dn, w_proj_dn,
                 w_alpha, b_alpha, norm_head_gla, w_proj_gla, w_out):
    f32 = jnp.float32
    bsz, L, _ = h.shape
    proj = h @ w_in
    splits = np.cumsum(IN_SPLITS)[:-1].tolist()
    (q_dn, k_dn, v_dn, z_dn, a_dn, b_dn, q_gla, k_gla, v_gla, r_gla, lr_gla,
     gate_dn, gate_gla) = jnp.split(proj, splits, axis=-1)
    qkv = jax.nn.silu(causal_conv(jnp.concatenate([q_dn, k_dn, v_dn], -1), conv_dn)).astype(f32)
    q_dn, k_dn, v_dn = jnp.split(qkv, [DN_QK, 2 * DN_QK], axis=-1)
    q_dn = l2norm(q_dn.reshape(bsz, L, DN_HEADS, DN_HEAD_DIM))
    k_dn = l2norm(k_dn.reshape(bsz, L, DN_HEADS, DN_HEAD_DIM))
    v_dn = v_dn.reshape(bsz, L, DN_HEADS, DN_V // DN_HEADS)
    g = -jnp.exp(a_log.astype(f32)) * jax.nn.softplus(a_dn.astype(f32) + dt_bias.astype(f32))
    beta = jax.nn.sigmoid(b_dn.astype(f32))
    o_dn = gated_delta_rule(q_dn, k_dn, v_dn, g, beta)
    o_dn = rmsnorm(o_dn, norm_head_dn) * jax.nn.silu(z_dn.astype(f32).reshape(bsz, L, DN_HEADS, -1))
    y_dn = o_dn.reshape(bsz, L, DN_V).astype(h.dtype) @ w_proj_dn
    log_alpha = jax.nn.log_sigmoid((lr_gla @ w_alpha).astype(f32) + b_alpha.astype(f32)) / GLA_TAU
    o_gla = gla_attention(q_gla.astype(f32).reshape(bsz, L, GLA_HEADS, GLA_KEY_DIM),
                          k_gla.astype(f32).reshape(bsz, L, GLA_HEADS, GLA_KEY_DIM),
                          v_gla.astype(f32).reshape(bsz, L, GLA_HEADS, GLA_VAL_DIM),
                          log_alpha.reshape(bsz, L, GLA_HEADS, GLA_KEY_DIM))
    o_gla = rmsnorm(o_gla, norm_head_gla) * jax.nn.silu(r_gla.astype(f32).reshape(bsz, L, GLA_HEADS, GLA_VAL_DIM))
    y_gla = o_gla.reshape(bsz, L, GLA_V).astype(h.dtype) @ w_proj_gla
    merged = jax.nn.sigmoid(gate_dn) * y_dn + jax.nn.sigmoid(gate_gla) * y_gla
    return merged @ w_out


def hier_moe(h, w_group, b_group, w_router, b_router, w1, w3, w2):
    f32 = jnp.float32
    bsz, L, d = h.shape
    T = bsz * L
    xf = h.reshape(T, d)
    xr = xf.astype(f32)
    g_logits = xr @ w_group.astype(f32) + b_group.astype(f32)
    g_sel = jnp.argmax(g_logits, axis=-1)
    g_w = jnp.take_along_axis(jax.nn.softmax(g_logits, -1), g_sel[:, None], axis=1)[:, 0]
    e_logits = (xr @ w_router.astype(f32) + b_router.astype(f32)).reshape(T, N_GROUPS, EXPERTS_PER_GROUP)
    e_in = jnp.take_along_axis(e_logits, g_sel[:, None, None], axis=1)[:, 0]
    top_v, top_i = lax.top_k(e_in, TOP_K)
    gate = jax.nn.softmax(top_v, axis=-1) * g_w[:, None]
    expert_id = g_sel[:, None] * EXPERTS_PER_GROUP + top_i
    M = T * TOP_K
    flat_e = expert_id.reshape(M).astype(jnp.int32)
    flat_tok = jnp.repeat(jnp.arange(T, dtype=jnp.int32), TOP_K)
    order = jnp.argsort(flat_e)
    se, stok, sw = flat_e[order], flat_tok[order], gate.reshape(M)[order]
    sizes = jnp.bincount(flat_e, length=N_EXPERTS)
    starts = jnp.cumsum(sizes) - sizes
    padded = (sizes + MOE_BLOCK - 1) // MOE_BLOCK * MOE_BLOCK
    pends = jnp.cumsum(padded)
    pstarts = pends - padded
    slot = pstarts[se] + (jnp.arange(M, dtype=jnp.int32) - starts[se])
    n_blocks = M // MOE_BLOCK + N_EXPERTS
    P = n_blocks * MOE_BLOCK
    slot_tok = jnp.full((P,), T, jnp.int32).at[slot].set(stok)
    x_ext = jnp.concatenate([xf, jnp.zeros((1, d), xf.dtype)], axis=0)
    xb = x_ext[slot_tok].reshape(n_blocks, MOE_BLOCK, d)
    block_expert = jnp.clip(jnp.searchsorted(pends, jnp.arange(n_blocks) * MOE_BLOCK, side='right'),
                            0, N_EXPERTS - 1)

    def expert_block(args):
        xblk, e = args
        hid = jax.nn.silu(xblk @ w1[e]) * (xblk @ w3[e])
        return hid @ w2[e]

    yb = lax.map(expert_block, (xb, block_expert)).reshape(P, d)
    y = jnp.zeros((T, d), yb.dtype).at[stok].add(yb[slot] * sw[:, None].astype(yb.dtype))
    return y.reshape(bsz, L, d).astype(h.dtype)


def setup_inputs(seed: int = 0) -> dict:
    key = jax.random.key(seed)
    ks = jax.random.split(key, 24)

    def nrm(k, shape, scale):
        return jax.random.normal(k, shape, jnp.float32) * scale

    def gain(k, shape):
        return 1.0 + 0.05 * jax.random.normal(k, shape, jnp.float32)

    dt = jnp.exp(jax.random.uniform(ks[5], (DEPTH, DN_HEADS), jnp.float32,
                                    minval=float(np.log(1e-3)), maxval=float(np.log(1e-1))))
    return {
        'x': nrm(ks[0], (BATCH, SEQ, D_MODEL), 1.0),
        'meta_tokens': nrm(ks[1], (N_META, D_MODEL), 1.0),
        'norm_mix': gain(ks[2], (DEPTH, D_MODEL)),
        'w_in': nrm(ks[3], (DEPTH, D_MODEL, D_IN), D_MODEL ** -0.5),
        'conv_dn': nrm(ks[4], (DEPTH, CONV_WIDTH, DN_QK * 2 + DN_V), CONV_WIDTH ** -0.5),
        'a_log': jnp.log(jax.random.uniform(ks[6], (DEPTH, DN_HEADS), jnp.float32, minval=1.0, maxval=16.0)),
        'dt_bias': dt + jnp.log(-jnp.expm1(-dt)),
        'norm_head_dn': gain(ks[7], (DEPTH, DN_HEAD_DIM)),
        'w_proj_dn': nrm(ks[8], (DEPTH, DN_V, D_MODEL), DN_V ** -0.5),
        'w_alpha': nrm(ks[9], (DEPTH, GLA_RANK, GLA_QK), GLA_RANK ** -0.5),
        'b_alpha': nrm(ks[10], (DEPTH, GLA_QK), 0.1),
        'norm_head_gla': gain(ks[11], (DEPTH, GLA_VAL_DIM)),
        'w_proj_gla': nrm(ks[12], (DEPTH, GLA_V, D_MODEL), GLA_V ** -0.5),
        'w_out': nrm(ks[13], (DEPTH, D_MODEL, D_MODEL), D_MODEL ** -0.5),
        'norm_ffn': gain(ks[14], (DEPTH, D_MODEL)),
        'w_group': nrm(ks[15], (DEPTH, D_MODEL, N_GROUPS), D_MODEL ** -0.5),
        'b_group': nrm(ks[16], (DEPTH, N_GROUPS), 0.01),
        'w_router': nrm(ks[17], (DEPTH, D_MODEL, N_EXPERTS), D_MODEL ** -0.5),
        'b_router': nrm(ks[18], (DEPTH, N_EXPERTS), 0.01),
        'w1': nrm(ks[19], (DEPTH, N_EXPERTS, D_MODEL, D_EXPERT), D_MODEL ** -0.5),
        'w3': nrm(ks[20], (DEPTH, N_EXPERTS, D_MODEL, D_EXPERT), D_MODEL ** -0.5),
        'w2': nrm(ks[21], (DEPTH, N_EXPERTS, D_EXPERT, D_MODEL), D_EXPERT ** -0.5),
        'norm_final': gain(ks[22], (D_MODEL,)),
    }


def reference(x, meta_tokens, norm_mix, w_in, conv_dn, a_log, dt_bias, norm_head_dn, w_proj_dn,
              w_alpha, b_alpha, norm_head_gla, w_proj_gla, w_out, norm_ffn, w_group, b_group,
              w_router, b_router, w1, w3, w2, norm_final):
    bsz = x.shape[0]
    meta = jnp.broadcast_to(meta_tokens[None].astype(x.dtype), (bsz, N_META, D_MODEL))
    h = jnp.concatenate([meta, x], axis=1)
    for i in range(DEPTH):
        h = h + hybrid_mixer(rmsnorm(h, norm_mix[i]), w_in[i], conv_dn[i], a_log[i], dt_bias[i],
                             norm_head_dn[i], w_proj_dn[i], w_alpha[i], b_alpha[i],
                             norm_head_gla[i], w_proj_gla[i], w_out[i])
        h = h + hier_moe(rmsnorm(h, norm_ffn[i]), w_group[i], b_group[i], w_router[i], b_router[i],
                         w1[i], w3[i], w2[i])
    return rmsnorm(h, norm_final)[:, N_META:]
```

```cpp
#include <hip/hip_runtime.h>
#include <hip/hip_cooperative_groups.h>
#include <cstdio>
#include <cstdint>
#include <cstring>
namespace cg = cooperative_groups;

#define DI __device__ __forceinline__
#define LAS __attribute__((address_space(3)))
typedef unsigned short bf16;
typedef short bf16x8 __attribute__((ext_vector_type(8)));
typedef float f32x4 __attribute__((ext_vector_type(4)));
typedef float f32x16 __attribute__((ext_vector_type(16)));
typedef unsigned u32x4 __attribute__((ext_vector_type(4)));
typedef unsigned u32x2 __attribute__((ext_vector_type(2)));
typedef __bf16 bf16x2_t __attribute__((ext_vector_type(2)));
typedef float f32x2_t __attribute__((ext_vector_type(2)));

constexpr int DM = 1024, BATCH = 32, SEQ = 2048, NMETA = 16, LP = 2112, NCH = 33;
constexpr int TP = BATCH * LP;
constexpr int TR = BATCH * SEQ;
constexpr int N1 = 5376;
constexpr int NGCH = BATCH * NCH;
constexpr int NIT_DN = NGCH * 8, NIT_GLA = NGCH * 4;
constexpr int MAXTILES = 576, MAXSLOTS = MAXTILES * 256;
constexpr float EPS = 1e-6f;
constexpr int NTHREADS = 512;
constexpr int LDS_BYTES = 163840;

constexpr size_t MiB = 1u << 20;
constexpr size_t XN8_OFF = 144 * MiB;
#define H1HI(base_, t_) ((base_) + ((size_t)((t_) >> 11) * LP + 64 + ((t_) & 2047)) * 2048 + 1024)
constexpr size_t WS_CTL = 0;
#define WS_OG8 (WS_EXT + 64 * MiB)
constexpr size_t WS_W1T = 1 * MiB;
constexpr size_t WS_WZR = 12 * MiB;
constexpr size_t WS_WG = 16 * MiB;
constexpr size_t WS_WPDN = 20 * MiB, WS_WPGLA = 22 * MiB, WS_WOUT = 24 * MiB;
constexpr size_t WS_WRT = 26 * MiB;
constexpr size_t WS_SMALL = 27 * MiB;
constexpr size_t WS_HALO = 36 * MiB;
constexpr size_t WS_SSQ_DN = 55 * MiB;
constexpr size_t WS_SSQ_GLA = 58 * MiB;
constexpr size_t WS_SC_DN = 61 * MiB;
constexpr size_t WS_EBL = 64 * MiB;
constexpr size_t WS_ROUTE = 67 * MiB;
constexpr size_t WS_PDN = 72 * MiB;
constexpr size_t WS_PGLA = 468 * MiB;
constexpr size_t WS_EXT = 732 * MiB;
constexpr size_t WS_ATT = 930 * MiB;
constexpr size_t WS_END = 963 * MiB;
constexpr size_t WS_WEXP13 = WS_EXT;
constexpr size_t WS_WEXP2 = WS_EXT + 128 * MiB;
constexpr size_t WS_XB = WS_PDN;
constexpr size_t WS_H = WS_PDN + 128 * MiB;
constexpr size_t WS_Y = WS_PDN + 252 * MiB;
static_assert(WS_Y + (size_t)MAXSLOTS * 1024 <= WS_PGLA && WS_H + (size_t)MAXSLOTS * 512 <= WS_Y, "MoE overlays");
constexpr size_t RT_E = 0;
constexpr size_t RT_G = 512 * 1024;
constexpr size_t RT_RSTD = 1024 * 1024;
constexpr size_t RT_HIST = 1280 * 1024;
constexpr size_t RT_STOK = 1536 * 1024;
constexpr size_t RT_STK = 2176 * 1024;
constexpr size_t RT_SGATE = 2816 * 1024;
constexpr size_t RT_SRSTD = 3456 * 1024;
constexpr size_t RT_TEXP = 4096 * 1024;
constexpr size_t RT_TSLOT = 4200 * 1024;
static_assert(RT_TSLOT + (size_t)TR * 8 <= 5 * MiB && RT_TEXP + (MAXTILES + 1) * 4 <= RT_TSLOT, "route map");
static_assert(WS_EXT + (size_t)NIT_DN * 24576 <= WS_ATT && WS_ATT + (size_t)NIT_GLA * 8192 <= WS_END, "ws map");
static_assert(WS_PDN + (size_t)TP * 3072 * 2 <= WS_PGLA && WS_PGLA + (size_t)TP * 2048 * 2 <= WS_EXT, "ws map 2");

DI unsigned pk2(float lo, float hi) { f32x2_t v = {lo, hi}; bf16x2_t b = __builtin_convertvector(v, bf16x2_t); return __builtin_bit_cast(unsigned, b); }
DI float bflo(unsigned u) { return __uint_as_float(u << 16); }
DI float bfhi(unsigned u) { return __uint_as_float(u & 0xffff0000u); }
DI float bf2f(bf16 b) { return __uint_as_float(((unsigned)b) << 16); }
DI bf16 f2bf(float f) { return (bf16)(pk2(f, 0.f) & 0xffffu); }
typedef int v8i_t __attribute__((ext_vector_type(8)));
typedef int v4i_t __attribute__((ext_vector_type(4)));
DI unsigned pk4_fp8(float a, float b, float c, float d) { int w = 0; w = __builtin_amdgcn_cvt_pk_fp8_f32(a, b, w, false); w = __builtin_amdgcn_cvt_pk_fp8_f32(c, d, w, true); return (unsigned)w; }
DI float sigmoidf_(float x) { return __builtin_amdgcn_rcpf(1.f + __expf(-x)); }
DI float siluf_(float x) { return x * __builtin_amdgcn_rcpf(1.f + __expf(-x)); }
DI float softplusf_(float x) { return x > 20.f ? x : log1pf(__expf(x)); }
DI float logsigmoidf_(float x) { return fminf(x, 0.f) - __logf(1.f + __expf(-fabsf(x))); }
DI float wave_sum(float v) {
#pragma unroll
    for (int o = 1; o < 64; o <<= 1) v += __shfl_xor(v, o);
    return v;
}
#define LDS_WAIT() asm volatile("s_waitcnt lgkmcnt(0)" ::: "memory")
DI int rowmap(int pm) { return (pm >> 3) * LP + 64 + (pm & 7) * 256; }
DI int tok2row(int t) { return (t >> 11) * LP + 64 + (t & 2047); }

struct Params { const float* in[23]; float* out; unsigned char* ws; };

namespace pg8 {
constexpr int BM = 256, BK = 64, HALF = 128, HTB = HALF * BK * 2, STAGE_BYTES = 8 * HTB;
DI int lds_byte(int r, int c) { const int st = (r >> 4) * 2 + (c >> 5), rr = r & 15, cc = c & 31, ob = rr * 64 + cc * 2; return st * 1024 + (ob ^ (((ob >> 9) & 1) << 5)); }
DI void stage_rc(int b, int& R, int& C) { const int st = b / 1024, sb = b % 1024, swz = sb ^ (((sb >> 9) & 1) << 5); R = (st >> 1) * 16 + swz / 64; C = (st & 1) * 32 + (swz % 64) / 2; }
DI int perm32(int rho) { const int n = rho >> 4, i = rho & 15; return 8 * (i >> 2) + 4 * n + (i & 3); }
struct Unit { const char* a; const char* b; const int* gidx; int pm, pn, aux; };
typedef f32x4 Acc[2][2][4][2];

template <class Epi, class Sched, bool GATHER, bool FP8 = false>
DI void gemm_phase(LAS unsigned char* lds, const int K, const int lda, const Sched& S, const Epi& E) {
    int tid_ = threadIdx.x; asm volatile("" : "+v"(tid_));
    const int tid = tid_, wid = __builtin_amdgcn_readfirstlane(tid >> 6), lane = tid & 63, wr = wid >> 2, wc = wid & 3, fr = lane & 15, fq = lane >> 4;
    int nt_ = K / BK; asm volatile("" : "+s"(nt_)); const int nt = nt_;
    unsigned vA[2][2], nA[2][2], voffB[2]; int Rs[2], Cs[2];
#pragma unroll
    for (int i = 0; i < 2; ++i) { int R, C; stage_rc(tid * 16 + i * 8192, R, C); Rs[i] = R; Cs[i] = C; const int Rb = (R & ~31) + perm32(R & 31);
        voffB[i] = (unsigned)(Rb * K + C) * 2u;
        vA[0][i] = (unsigned)(R * lda + C) * 2u; vA[1][i] = (unsigned)((R + HALF) * lda + C) * 2u; nA[0][i] = vA[0][i]; nA[1][i] = vA[1][i]; }
    const size_t kstep = (size_t)(BK * 2);
    const size_t hstepB = (size_t)HALF * K * 2;
    const unsigned ldsw = (unsigned)wid * 1024u;
    const int aoff = lds_byte(wr * 64 + fr, fq * 8), boff = lds_byte(wc * 32 + fr, fq * 8);
#define PG8_SA(b, h) (((b) * 2 + (h)) * HTB)
#define PG8_SB(b, h) ((4 + (b) * 2 + (h)) * HTB)
#define PG8_STAGEB(bufoff, gbase) do { _Pragma("unroll") for (int _i = 0; _i < 2; ++_i) \
        __builtin_amdgcn_global_load_lds((const unsigned*)((const char*)(gbase) + voffB[_i]), (LAS unsigned*)(lds + (bufoff) + ldsw + _i * 8192), 16, 0, 0); } while (0)
#define PG8_STAGEA(bufoff, gbase, v0, v1) do { \
        __builtin_amdgcn_global_load_lds((const unsigned*)((const char*)(gbase) + (v0)), (LAS unsigned*)(lds + (bufoff) + ldsw), 16, 0, 0); \
        __builtin_amdgcn_global_load_lds((const unsigned*)((const char*)(gbase) + (v1)), (LAS unsigned*)(lds + (bufoff) + ldsw + 8192), 16, 0, 0); } while (0)
#define PG8_LDA(dst, b, h) do { if constexpr (FP8) { _Pragma("unroll") for (int m = 0; m < 4; ++m) { const v4i_t lo_ = *(const LAS v4i_t*)(lds + PG8_SA(b, h) + aoff + m * 2048), hi_ = *(const LAS v4i_t*)(lds + PG8_SA(b, h) + aoff + m * 2048 + 1024); \
            dst##8[m] = __builtin_shufflevector(lo_, hi_, 0, 1, 2, 3, 4, 5, 6, 7); } } \
        else { _Pragma("unroll") for (int m = 0; m < 4; ++m) _Pragma("unroll") for (int k = 0; k < 2; ++k) dst[m][k] = *(const LAS bf16x8*)(lds + PG8_SA(b, h) + aoff + m * 2048 + k * 1024); } } while (0)
#define PG8_LDB(dst, b, h) do { if constexpr (FP8) { _Pragma("unroll") for (int n = 0; n < 2; ++n) { const v4i_t lo_ = *(const LAS v4i_t*)(lds + PG8_SB(b, h) + boff + n * 2048), hi_ = *(const LAS v4i_t*)(lds + PG8_SB(b, h) + boff + n * 2048 + 1024); \
            dst##8[n] = __builtin_shufflevector(lo_, hi_, 0, 1, 2, 3, 4, 5, 6, 7); } } \
        else { _Pragma("unroll") for (int n = 0; n < 2; ++n) _Pragma("unroll") for (int k = 0; k < 2; ++k) dst[n][k] = *(const LAS bf16x8*)(lds + PG8_SB(b, h) + boff + n * 2048 + k * 1024); } } while (0)
#define PG8_MMA(ai, bj, At, Bt) do { __builtin_amdgcn_s_setprio(1); \
        if constexpr (FP8) { asm volatile("s_nop 4"); _Pragma("unroll") for (int m = 0; m < 4; ++m) _Pragma("unroll") for (int n = 0; n < 2; ++n) \
            asm volatile("s_nop 1\n\tv_mfma_scale_f32_16x16x128_f8f6f4 %0, %1, %2, %0, %3, %3 op_sel_hi:[0,0,0]" : "+v"(acc[ai][bj][m][n]) : "v"(Bt##8[n]), "v"(At##8[m]), "v"(one_scale)); } \
        else { _Pragma("unroll") for (int m = 0; m < 4; ++m) _Pragma("unroll") for (int n = 0; n < 2; ++n) _Pragma("unroll") for (int k = 0; k < 2; ++k) \
            acc[ai][bj][m][n] = __builtin_amdgcn_mfma_f32_16x16x32_bf16(Bt[n][k], At[m][k], acc[ai][bj][m][n], 0, 0, 0); } \
        __builtin_amdgcn_s_setprio(0); } while (0)
#define PG8_WAIT_V(n) asm volatile("s_waitcnt vmcnt(" #n ")" ::: "memory")
#define PG8_WAIT_L(n) asm volatile("s_waitcnt lgkmcnt(" #n ")" ::: "memory")
#define PG8_BAR __builtin_amdgcn_s_barrier()
#define PG8_SCHED __builtin_amdgcn_sched_barrier(0)
#define PG8_GIDX(dst, u) do { if constexpr (GATHER) { _Pragma("unroll") for (int _h = 0; _h < 2; ++_h) _Pragma("unroll") for (int _i = 0; _i < 2; ++_i) \
        dst[_h][_i] = (unsigned)((u).gidx[Rs[_i] + _h * HALF]) * (unsigned)(lda * 2) + (unsigned)(Cs[_i] * 2); } } while (0)
    Unit cur, nxt; int ui = 0;
    if (!S.next(0, cur)) return;
    Acc acc;
#pragma unroll
    for (int a = 0; a < 2; ++a)
#pragma unroll
        for (int b = 0; b < 2; ++b)
#pragma unroll
            for (int m = 0; m < 4; ++m)
#pragma unroll
                for (int n = 0; n < 2; ++n) acc[a][b][m][n] = (f32x4){0.f, 0.f, 0.f, 0.f};
    int one_scale = 0x7f7f7f7f; asm volatile("" : "+v"(one_scale));
    bf16x8 At[4][2], B0[2][2], B1[2][2];
    v8i_t At8[4], B08[2], B18[2];
    const char* cA = cur.a; const char* cB = cur.b;
    PG8_GIDX(vA, cur);
    PG8_STAGEB(PG8_SB(0, 0), cB); PG8_STAGEB(PG8_SB(0, 1), cB + hstepB); PG8_STAGEA(PG8_SA(0, 0), cA, vA[0][0], vA[0][1]); PG8_STAGEA(PG8_SA(0, 1), cA, vA[1][0], vA[1][1]);
    if (wr == 1) PG8_BAR;
    PG8_WAIT_V(2); PG8_BAR;
    PG8_STAGEB(PG8_SB(1, 0), cB + kstep); PG8_STAGEA(PG8_SA(1, 0), cA + kstep, vA[0][0], vA[0][1]); PG8_STAGEB(PG8_SB(1, 1), cB + hstepB + kstep);
    PG8_WAIT_V(6); PG8_BAR;
    for (;;) {
        const bool has_next = S.next(ui + 1, nxt);
        const char* nAp = has_next ? nxt.a : cA; const char* nBp = has_next ? nxt.b : cB;
        for (int t = 0; t < nt; t += 2) {
            const bool last = (t == nt - 2);
            const char* a1 = cA + (size_t)(t + 1) * kstep;
            const char* a2 = last ? nAp : cA + (size_t)(t + 2) * kstep; const char* b2 = last ? nBp : cB + (size_t)(t + 2) * kstep;
            const char* a3 = a2 + kstep; const char* b3 = b2 + kstep;
            unsigned x00 = vA[0][0], x01 = vA[0][1], x10 = vA[1][0], x11 = vA[1][1];
            if constexpr (GATHER) { if (last && has_next) { PG8_GIDX(nA, nxt); x00 = nA[0][0]; x01 = nA[0][1]; x10 = nA[1][0]; x11 = nA[1][1]; } }
            PG8_LDB(B0, 0, 0); PG8_LDB(B1, 0, 1); PG8_SCHED; PG8_LDA(At, 0, 0); PG8_STAGEA(PG8_SA(1, 1), a1, vA[1][0], vA[1][1]);
            PG8_WAIT_V(8); PG8_WAIT_L(0); PG8_BAR; PG8_MMA(0, 0, At, B0); PG8_MMA(0, 1, At, B1); PG8_BAR; PG8_SCHED;
            PG8_LDA(At, 0, 1); PG8_STAGEB(PG8_SB(0, 0), b2); PG8_STAGEB(PG8_SB(0, 1), b2 + hstepB); PG8_STAGEA(PG8_SA(0, 0), a2, x00, x01);
            PG8_WAIT_V(8); PG8_WAIT_L(0); PG8_BAR; PG8_MMA(1, 0, At, B0); PG8_MMA(1, 1, At, B1); PG8_BAR; PG8_SCHED;
            PG8_LDB(B0, 1, 0); PG8_LDB(B1, 1, 1); PG8_SCHED; PG8_LDA(At, 1, 0); PG8_STAGEA(PG8_SA(0, 1), a2, x10, x11);
            PG8_WAIT_V(8); PG8_WAIT_L(0); PG8_BAR; PG8_MMA(0, 0, At, B0); PG8_MMA(0, 1, At, B1); PG8_BAR; PG8_SCHED;
            PG8_LDA(At, 1, 1); PG8_STAGEB(PG8_SB(1, 0), b3); PG8_STAGEB(PG8_SB(1, 1), b3 + hstepB); PG8_STAGEA(PG8_SA(1, 0), a3, x00, x01);
            PG8_WAIT_V(8); PG8_WAIT_L(0); PG8_BAR; PG8_MMA(1, 0, At, B0); PG8_MMA(1, 1, At, B1); PG8_BAR; PG8_SCHED;
        }
        if (wr == 0) PG8_BAR;
        if constexpr (FP8) asm volatile("s_nop 15\n\ts_nop 15" ::: "memory");
        E(acc, cur, wr, wc, fr, fq);
        if (!has_next) break;
#pragma unroll
        for (int a = 0; a < 2; ++a)
#pragma unroll
            for (int b = 0; b < 2; ++b)
#pragma unroll
                for (int m = 0; m < 4; ++m)
#pragma unroll
                    for (int n = 0; n < 2; ++n) acc[a][b][m][n] = (f32x4){0.f, 0.f, 0.f, 0.f};
        cur = nxt; cA = nAp; cB = nBp; ++ui;
        if constexpr (GATHER) {
#pragma unroll
            for (int h = 0; h < 2; ++h)
#pragma unroll
                for (int i = 0; i < 2; ++i) vA[h][i] = nA[h][i]; }
        if (wr == 1) PG8_BAR;
    }
    PG8_WAIT_V(0);
    PG8_BAR;
#undef PG8_SA
#undef PG8_SB
#undef PG8_STAGEA
#undef PG8_STAGEB
#undef PG8_LDA
#undef PG8_LDB
#undef PG8_MMA
#undef PG8_WAIT_V
#undef PG8_WAIT_L
#undef PG8_BAR
#undef PG8_SCHED
#undef PG8_GIDX
}
}

template <class Map> struct DenseOrder {
    int nM, nN, nwg, G, c; Map map;
    DI void init(int nM_, int nN_, int G_, int c_, const Map& m) { nM = nM_; nN = nN_; nwg = nM * nN; G = G_; c = c_; map = m; }
    DI bool next(int i, pg8::Unit& u) const { return next_L((long)i * G + c, u); }
    DI bool next_L(const long L, pg8::Unit& u) const {
        if (L >= nwg) return false;
        int wgid = (int)L; { const int q = nwg / 8, r = nwg % 8, xcd = wgid % 8, off = wgid / 8; wgid = (xcd < r ? xcd * (q + 1) : r * (q + 1) + (xcd - r) * q) + off; }
        const int nig = 8 * nN, gid = wgid / nig, fm = gid * 8, gsz = (nM - fm) < 8 ? (nM - fm) : 8;
        u.pm = fm + ((wgid % nig) % gsz); u.pn = (wgid % nig) / gsz; u.gidx = nullptr; u.aux = 0;
        map(u); return true;
    }
};
template <class Map> struct SplitOrder {
    DenseOrder<Map> D; int NL, EX, G, c; bool on;
    DI void init(int nM_, int nN_, int G_, int c_, const Map& m, int NL_, int EX_) { NL = NL_; EX = EX_; G = G_; c = c_; on = (G_ == 256) && (NL_ * 256 + EX_ * 128 == nM_ * nN_); D.init(nM_, nN_, G_, on ? 0 : c_, m); }
    DI bool next(int i, pg8::Unit& u) const {
        if (!on) return D.next(i, u);
        const bool light = ((c >> 3) & 1) == 0;
        long L;
        if (i < NL) L = (long)i * 256 + c;
        else { if (light || i >= NL + EX) return false; const int d = (c & 7) | ((c >> 4) << 3); L = (long)NL * 256 + (long)(i - NL) * 128 + d; }
        return D.next_L(L, u);
    }
};
struct MapPlain { const char* A; const char* B; size_t astride, bstride;
    DI void operator()(pg8::Unit& u) const { u.a = A + (size_t)u.pm * astride; u.b = B + (size_t)u.pn * bstride; } };
struct MapReal { const char* A; const char* B; size_t arow, bstride;
    DI void operator()(pg8::Unit& u) const { u.a = A + (size_t)rowmap(u.pm) * arow; u.b = B + (size_t)u.pn * bstride; } };
struct ExpertOrder {
    int ntiles, G, c; const int* texp; const int* stok; const char* A; const char* B; size_t atile, bexp, btile;
    DI bool next(int i, pg8::Unit& u) const {
        const long L = (long)i * G + c; if (L >= (long)ntiles * 4) return false;
        const int tile = (int)(L >> 2), pn = (int)(L & 3);
        int e; { const int off_ = __builtin_amdgcn_readfirstlane(tile << 2); asm volatile("s_load_dword %0, %1, %2\n\ts_waitcnt lgkmcnt(0)" : "=s"(e) : "s"(texp), "s"(off_) : "memory"); }
        u.pm = tile; u.pn = pn; u.aux = e; u.gidx = stok + tile * 256; u.a = A + (size_t)tile * atile; u.b = B + (size_t)e * bexp + (size_t)pn * btile; return true;
    }
};

#define EPI_LOOP_ROWS for (int ai = 0; ai < 2; ++ai) _Pragma("unroll") for (int m = 0; m < 4; ++m)
DI u32x4 pack8(const f32x4& v0, const f32x4& v1) { u32x4 w; w.x = pk2(v0[0], v0[1]); w.y = pk2(v0[2], v0[3]); w.z = pk2(v1[0], v1[1]); w.w = pk2(v1[2], v1[3]); return w; }
DI void unpack8(const u32x4 w, float* f) { f[0] = bflo(w.x); f[1] = bfhi(w.x); f[2] = bflo(w.y); f[3] = bfhi(w.y); f[4] = bflo(w.z); f[5] = bfhi(w.z); f[6] = bflo(w.w); f[7] = bfhi(w.w); }

struct EpiProj {
    bf16* pdn; bf16* pgla; bf16* halo; float* small;
    DI void operator()(const pg8::Acc& acc, const pg8::Unit& u, int wr, int wc, int fr, int fq) const {
        const int row0 = u.pm * 256 + wr * 64 + fr, cl = wc * 32 + 8 * fq;
        if (u.pn < 12) {
#pragma unroll
            EPI_LOOP_ROWS { const int R = row0 + ai * 128 + m * 16;
#pragma unroll
                for (int bj = 0; bj < 2; ++bj) { const int col = u.pn * 256 + bj * 128 + cl; const u32x4 w = pack8(acc[ai][bj][m][0], acc[ai][bj][m][1]);
                    *(u32x4*)(pdn + (size_t)R * 3072 + col) = w;
                    if ((R & 63) >= 61) *(u32x4*)(halo + ((size_t)(R >> 6) * 3 + ((R & 63) - 61)) * 3072 + col) = w; } }
        } else if (u.pn < 20) {
#pragma unroll
            EPI_LOOP_ROWS { const int R = row0 + ai * 128 + m * 16;
#pragma unroll
                for (int bj = 0; bj < 2; ++bj) { const int col = (u.pn - 12) * 256 + bj * 128 + cl;
                    *(u32x4*)(pgla + (size_t)R * 2048 + col) = pack8(acc[ai][bj][m][0], acc[ai][bj][m][1]); } }
        } else if (wc == 0) {
#pragma unroll
            EPI_LOOP_ROWS { const int R = row0 + ai * 128 + m * 16; float* p = small + (size_t)R * 32 + 8 * fq;
                *(f32x4*)p = acc[ai][0][m][0]; *(f32x4*)(p + 4) = acc[ai][0][m][1]; }
        }
    }
};
struct EpiZR {
    bf16* pdn; bf16* pgla; const float* ssq_dn; const float* ssq_gla; const float* nw_dn; const float* nw_gla; unsigned char* og8;
    DI void operator()(const pg8::Acc& acc, const pg8::Unit& u, int wr, int wc, int fr, int fq) const {
        const int R0 = rowmap(u.pm) + wr * 64 + fr, cl = wc * 32 + 8 * fq;
        const bool dn = u.pn < 4; const int hd = u.pn - 4;
        f32x4 nw[2][2];
#pragma unroll
        for (int bj = 0; bj < 2; ++bj) { const float* p = dn ? nw_dn + cl : nw_gla + bj * 128 + cl; nw[bj][0] = *(const f32x4*)p; nw[bj][1] = *(const f32x4*)(p + 4); }
#pragma unroll
        for (int am = 0; am < 4; ++am) { const int ai = am >> 1, mb = (am & 1) * 2;
            u32x4 ov[2][2]; float sa[2][2], sb[2][2];
#pragma unroll
            for (int mm = 0; mm < 2; ++mm) { const int R = R0 + ai * 128 + (mb + mm) * 16;
#pragma unroll
                for (int bj = 0; bj < 2; ++bj) {
                    const bf16* op = dn ? pdn + (size_t)R * 3072 + u.pn * 256 + bj * 128 + cl : pgla + (size_t)R * 2048 + 1024 + hd * 256 + bj * 128 + cl;
                    const float* sp = dn ? ssq_dn + (size_t)R * 8 + u.pn * 2 + bj : ssq_gla + (size_t)R * 8 + hd * 2;
                    ov[mm][bj] = *(const u32x4*)op; sa[mm][bj] = sp[0]; sb[mm][bj] = sp[dn ? 0 : 1]; } }
            __builtin_amdgcn_sched_barrier(0);
#pragma unroll
            for (int mm = 0; mm < 2; ++mm) { const int m = mb + mm; const int R = R0 + ai * 128 + m * 16;
#pragma unroll
                for (int bj = 0; bj < 2; ++bj) {
                    bf16* op = dn ? pdn + (size_t)R * 3072 + u.pn * 256 + bj * 128 + cl : pgla + (size_t)R * 2048 + 1024 + hd * 256 + bj * 128 + cl;
                    const float rs = rsqrtf(dn ? sa[mm][bj] * (1.f / 128.f) + EPS : (sa[mm][bj] + sb[mm][bj]) * (1.f / 256.f) + EPS);
                    float o[8]; unpack8(ov[mm][bj], o); f32x4 r0, r1;
#pragma unroll
                    for (int j = 0; j < 4; ++j) { r0[j] = o[j] * rs * nw[bj][0][j] * siluf_(acc[ai][bj][m][0][j]); r1[j] = o[4 + j] * rs * nw[bj][1][j] * siluf_(acc[ai][bj][m][1][j]); }
                    if (dn) *(u32x4*)op = pack8(r0, r1);
                    else { u32x2 w8; w8.x = pk4_fp8(r0[0], r0[1], r0[2], r0[3]); w8.y = pk4_fp8(r1[0], r1[1], r1[2], r1[3]);
                        *(u32x2*)(og8 + (size_t)(u.pm * 256 + wr * 64 + fr + ai * 128 + m * 16) * 1024 + hd * 256 + bj * 128 + cl) = w8; } } }
        }
    }
};
struct EpiStoreReal {
    bf16* dst; int ld; float scale;
    DI void operator()(const pg8::Acc& acc, const pg8::Unit& u, int wr, int wc, int fr, int fq) const {
        const int R0 = rowmap(u.pm) + wr * 64 + fr, cl = u.pn * 256 + wc * 32 + 8 * fq;
#pragma unroll
        EPI_LOOP_ROWS { const int R = R0 + ai * 128 + m * 16;
#pragma unroll
            for (int bj = 0; bj < 2; ++bj) *(u32x4*)(dst + (size_t)R * ld + cl + bj * 128) = pack8(acc[ai][bj][m][0] * scale, acc[ai][bj][m][1] * scale); }
    }
};
struct EpiMerge {
    const bf16* ydn; const bf16* ygla; bf16* merged;
    DI void operator()(const pg8::Acc& acc, const pg8::Unit& u, int wr, int wc, int fr, int fq) const {
        const int R0 = rowmap(u.pm) + wr * 64 + fr, col = u.pn * 128 + wc * 32 + 8 * fq;
        u32x4 ya[2][4], yb[2][4];
#pragma unroll
        for (int ai = 0; ai < 2; ++ai)
#pragma unroll
            for (int m = 0; m < 4; ++m) { const int R = R0 + ai * 128 + m * 16; ya[ai][m] = *(const u32x4*)(ydn + (size_t)R * 3072 + col); yb[ai][m] = *(const u32x4*)(ygla + (size_t)R * 3072 + col); }
        __builtin_amdgcn_sched_barrier(0);
#pragma unroll
        EPI_LOOP_ROWS { const int R = R0 + ai * 128 + m * 16;
            float a[8], b[8]; unpack8(ya[ai][m], a); unpack8(yb[ai][m], b);
            f32x4 r0, r1;
#pragma unroll
            for (int j = 0; j < 4; ++j) { r0[j] = sigmoidf_(acc[ai][0][m][0][j] * (1.f / 32.f)) * a[j] + sigmoidf_(acc[ai][1][m][0][j] * (1.f / 32.f)) * b[j];
                r1[j] = sigmoidf_(acc[ai][0][m][1][j] * (1.f / 32.f)) * a[4 + j] + sigmoidf_(acc[ai][1][m][1][j] * (1.f / 32.f)) * b[4 + j]; }
            *(u32x4*)(merged + (size_t)R * 2048 + col) = pack8(r0, r1); }
    }
};
struct EpiOut {
    const float* x; bf16* hlo; bf16* hhi;
    DI void operator()(const pg8::Acc& acc, const pg8::Unit& u, int wr, int wc, int fr, int fq) const {
        const int t0 = u.pm * 256 + wr * 64 + fr, cl = u.pn * 256 + wc * 32 + 8 * fq;
#pragma unroll
        for (int ai = 0; ai < 2; ++ai)
#pragma unroll
            for (int mp = 0; mp < 2; ++mp) {
                f32x4 xv[2][2][2];
#pragma unroll
                for (int m2 = 0; m2 < 2; ++m2)
#pragma unroll
                    for (int bj = 0; bj < 2; ++bj) { const size_t o = (size_t)(t0 + ai * 128 + (2 * mp + m2) * 16) * 1024 + cl + bj * 128; xv[m2][bj][0] = *(const f32x4*)(x + o); xv[m2][bj][1] = *(const f32x4*)(x + o + 4); }
                __builtin_amdgcn_sched_barrier(0);
#pragma unroll
                for (int m2 = 0; m2 < 2; ++m2)
#pragma unroll
                    for (int bj = 0; bj < 2; ++bj) { const int m = 2 * mp + m2, t = t0 + ai * 128 + m * 16, cc = cl + bj * 128;
                        const f32x4 v0 = xv[m2][bj][0] + acc[ai][bj][m][0], v1 = xv[m2][bj][1] + acc[ai][bj][m][1];
                        const u32x4 hi = pack8(v0, v1); float hf[8]; unpack8(hi, hf);
                        const f32x4 l0 = {v0[0] - hf[0], v0[1] - hf[1], v0[2] - hf[2], v0[3] - hf[3]}, l1 = {v1[0] - hf[4], v1[1] - hf[5], v1[2] - hf[6], v1[3] - hf[7]};
                        *(u32x4*)(H1HI(hhi, t) + cc) = hi; *(u32x4*)(hlo + (size_t)t * 1024 + cc) = pack8(l0, l1); }
                __builtin_amdgcn_sched_barrier(0);
            }
    }
};
struct EpiE1 {
    const float* srstd; unsigned char* H;
    DI void operator()(const pg8::Acc& acc, const pg8::Unit& u, int wr, int wc, int fr, int fq) const {
        const int s0 = u.pm * 256 + wr * 64 + fr, col = u.pn * 128 + wc * 32 + 8 * fq;
        float rsv[2][4];
#pragma unroll
        for (int ai = 0; ai < 2; ++ai)
#pragma unroll
            for (int m = 0; m < 4; ++m) rsv[ai][m] = srstd[s0 + ai * 128 + m * 16] * (1.f / 32.f);
        __builtin_amdgcn_sched_barrier(0);
#pragma unroll
        EPI_LOOP_ROWS { const int s = s0 + ai * 128 + m * 16; const float rs = rsv[ai][m]; f32x4 r0, r1;
#pragma unroll
            for (int j = 0; j < 4; ++j) { r0[j] = siluf_(rs * acc[ai][0][m][0][j]) * (rs * acc[ai][1][m][0][j]); r1[j] = siluf_(rs * acc[ai][0][m][1][j]) * (rs * acc[ai][1][m][1][j]); }
            u32x2 w; w.x = pk4_fp8(r0[0], r0[1], r0[2], r0[3]); w.y = pk4_fp8(r1[0], r1[1], r1[2], r1[3]);
            *(u32x2*)(H + (size_t)s * 512 + col) = w; }
    }
};
struct EpiE2 {
    const float* sgate; unsigned char* Y;
    DI void operator()(const pg8::Acc& acc, const pg8::Unit& u, int wr, int wc, int fr, int fq) const {
        const int s0 = u.pm * 256 + wr * 64 + fr, cl = u.pn * 256 + wc * 32 + 8 * fq;
        float gv[2][4];
#pragma unroll
        for (int ai = 0; ai < 2; ++ai)
#pragma unroll
            for (int m = 0; m < 4; ++m) gv[ai][m] = sgate[s0 + ai * 128 + m * 16] * (8.f / 16.f);
        __builtin_amdgcn_sched_barrier(0);
#pragma unroll
        EPI_LOOP_ROWS { const int s = s0 + ai * 128 + m * 16; const float g = gv[ai][m]; unsigned char* yp = Y + (size_t)s * 1024 + cl;
#pragma unroll
            for (int bj = 0; bj < 2; ++bj) { const f32x4 a0 = acc[ai][bj][m][0] * g, a1 = acc[ai][bj][m][1] * g; u32x2 w; w.x = pk4_fp8(a0[0], a0[1], a0[2], a0[3]); w.y = pk4_fp8(a1[0], a1[1], a1[2], a1[3]);
                *(u32x2*)(yp + bj * 128) = w; } }
    }
};

DI void transpose_item(const float* __restrict__ W, int ldw, int c0, int c1, int k0, const float* __restrict__ kscale,
                       bf16* __restrict__ WT, size_t drow0, int ldk, LAS float* scr, int lane) {
    const int j = lane & 31, col = (j < 16) ? (c0 + j) : (c1 + j - 16);
#pragma unroll 8
    for (int i = 0; i < 32; ++i) { const int kk = 2 * i + (lane >> 5); float v = W[(size_t)(k0 + kk) * ldw + col]; if (kscale) v *= kscale[k0 + kk]; scr[kk * 33 + j] = v; }
    LDS_WAIT();
    const int c = lane & 7;
#pragma unroll
    for (int jj = 0; jj < 4; ++jj) { const int n = (lane >> 3) + 8 * jj; const LAS float* s = scr + (8 * c) * 33 + n;
        u32x4 o; o.x = pk2(s[0 * 33], s[1 * 33]); o.y = pk2(s[2 * 33], s[3 * 33]); o.z = pk2(s[4 * 33], s[5 * 33]); o.w = pk2(s[6 * 33], s[7 * 33]);
        *(u32x4*)(WT + (drow0 + n) * ldk + k0 + 8 * c) = o; }
    LDS_WAIT();
}

DI void transpose_item8(const float* __restrict__ W, int ldw, int c0, int c1, int k0, const float* __restrict__ kscale, float scale,
                        unsigned char* __restrict__ WT, size_t drow0, int ldk, LAS float* scr, int lane) {
    const int j = lane & 31, col = (j < 16) ? (c0 + j) : (c1 + j - 16);
#pragma unroll 8
    for (int i = 0; i < 32; ++i) { const int kk = 2 * i + (lane >> 5); float v = W[(size_t)(k0 + kk) * ldw + col] * scale; if (kscale) v *= kscale[k0 + kk]; scr[kk * 33 + j] = v; }
    LDS_WAIT();
    const int c = lane & 7;
#pragma unroll
    for (int jj = 0; jj < 4; ++jj) { const int n = (lane >> 3) + 8 * jj; const LAS float* s = scr + (8 * c) * 33 + n;
        u32x2 o; o.x = pk4_fp8(s[0 * 33], s[1 * 33], s[2 * 33], s[3 * 33]); o.y = pk4_fp8(s[4 * 33], s[5 * 33], s[6 * 33], s[7 * 33]);
        *(u32x2*)(WT + (drow0 + n) * ldk + k0 + 8 * c) = o; }
    LDS_WAIT();
}

struct P0Item { const float* src; unsigned char* dst; size_t drow0; int ldw, c0, c1, k0, fp8; };
DI P0Item p0_decode(const Params& P, int r) {
    constexpr int I_W1 = 161 * 16, I_ZR = 64 * 16, I_G = 64 * 16, I_P = 32 * 16;
    P0Item x; x.src = P.in[3]; x.ldw = 9248; x.fp8 = 0;
    if (r < I_W1) { const int nb = r >> 4, kb = r & 15;
        if (nb < 96) { x.c0 = 32 * nb; x.c1 = x.c0 + 16; } else if (nb < 160) { x.c0 = 4112 + 32 * (nb - 96); x.c1 = x.c0 + 16; } else { x.c0 = 4096; x.c1 = 7184; }
        x.k0 = 64 * kb; x.dst = P.ws + WS_W1T; x.drow0 = (size_t)32 * nb; return x; }
    r -= I_W1;
    if (r < I_ZR) { const int nb = r >> 4, kb = r & 15; x.c0 = (nb < 32) ? 3072 + 32 * nb : 6160 + 32 * (nb - 32); x.c1 = x.c0 + 16; x.k0 = 64 * kb; x.dst = P.ws + WS_WZR; x.drow0 = (size_t)32 * nb; return x; }
    r -= I_ZR;
    if (r < I_G) { const int nb = r >> 4, kb = r & 15, pn = nb >> 3, q = nb & 7; x.c0 = (q < 4) ? 7200 + 128 * pn + 32 * q : 8224 + 128 * pn + 32 * (q - 4); x.c1 = x.c0 + 16; x.k0 = 64 * kb;
        x.dst = P.ws + WS_WG; x.drow0 = (size_t)32 * nb; x.fp8 = 1; return x; }
    r -= I_G;
    { const int which = r / I_P, rr = r % I_P, nb = rr >> 4, kb = rr & 15;
        x.src = which == 0 ? P.in[8] : (which == 1 ? P.in[12] : P.in[13]); x.ldw = 1024; x.c0 = 32 * nb; x.c1 = x.c0 + 16; x.k0 = 64 * kb;
        x.dst = P.ws + (which == 0 ? WS_WPDN : (which == 1 ? WS_WPGLA : WS_WOUT)); x.drow0 = (size_t)32 * nb; x.fp8 = (which == 1); }
    return x;
}
DI void p0_load(const P0Item& x, f32x4 (&v)[8], int lane) {
    const int row = lane >> 3, col = (((lane >> 2) & 1) ? x.c1 : x.c0) + 4 * (lane & 3);
#pragma unroll
    for (int i = 0; i < 8; ++i) v[i] = *(const f32x4*)(x.src + (size_t)(x.k0 + 8 * i + row) * x.ldw + col);
}
DI void phase_p0(const Params& P, LAS unsigned char* lds) {
    int tid_o = threadIdx.x; asm volatile("" : "+v"(tid_o)); const int tid = tid_o, lane = tid & 63, wave = __builtin_amdgcn_readfirstlane(tid >> 6);
    const int gw = blockIdx.x * 8 + wave, NGW = gridDim.x * 8;
    LAS float* scr = (LAS float*)(lds + wave * 8448);
    unsigned char* ws = P.ws;
    const float* w_in = P.in[3];
    constexpr int I_W1 = 161 * 16, I_ZR = 64 * 16, I_G = 64 * 16, I_P = 32 * 16;
    constexpr int NITEMS = I_W1 + I_ZR + I_G + 3 * I_P;
    { f32x4 v[8];
        int it = gw;
        if (it < NITEMS) { const P0Item x0 = p0_decode(P, it); p0_load(x0, v, lane); }
#pragma nounroll
        for (; it < NITEMS; it += NGW) {
            { const int row = lane >> 3, j0 = ((lane >> 2) & 1) * 16 + 4 * (lane & 3);
#pragma unroll
                for (int i = 0; i < 8; ++i) { LAS float* d = scr + (8 * i + row) * 33 + j0; d[0] = v[i][0]; d[1] = v[i][1]; d[2] = v[i][2]; d[3] = v[i][3]; } }
            LDS_WAIT();
            if (it + NGW < NITEMS) { const P0Item nxt = p0_decode(P, it + NGW); p0_load(nxt, v, lane); }
            { const P0Item cur = p0_decode(P, it); const int c = lane & 7;
#pragma unroll
                for (int jj = 0; jj < 4; ++jj) { const int n = (lane >> 3) + 8 * jj; const LAS float* s = scr + (8 * c) * 33 + n;
                    if (cur.fp8) { u32x2 o; o.x = pk4_fp8(s[0 * 33] * 32.f, s[1 * 33] * 32.f, s[2 * 33] * 32.f, s[3 * 33] * 32.f); o.y = pk4_fp8(s[4 * 33] * 32.f, s[5 * 33] * 32.f, s[6 * 33] * 32.f, s[7 * 33] * 32.f);
                        *(u32x2*)(cur.dst + (cur.drow0 + n) * 1024 + cur.k0 + 8 * c) = o; }
                    else { u32x4 o; o.x = pk2(s[0 * 33], s[1 * 33]); o.y = pk2(s[2 * 33], s[3 * 33]); o.z = pk2(s[4 * 33], s[5 * 33]); o.w = pk2(s[6 * 33], s[7 * 33]);
                        *(u32x4*)((bf16*)cur.dst + (cur.drow0 + n) * 1024 + cur.k0 + 8 * c) = o; } } }
            LDS_WAIT();
        } }
    { u32x4* z = (u32x4*)(ws + WS_W1T + (size_t)5152 * 1024 * 2); const int n16 = 224 * 1024 * 2 / 16;
        for (int i = blockIdx.x * NTHREADS + tid; i < n16; i += gridDim.x * NTHREADS) z[i] = (u32x4){0u, 0u, 0u, 0u}; }
    { bf16* wh = (bf16*)(ws + WS_WRT); bf16* wl = wh + 80 * 1024; const float* nf = P.in[14]; const float* wg = P.in[15]; const float* wrt = P.in[17];
        for (int i = blockIdx.x * NTHREADS + tid; i < 1024 * 80; i += gridDim.x * NTHREADS) { const int n = i >> 10, k = i & 1023;
            const float v = (n < 8 ? wg[k * 8 + n] : (n < 16 ? 0.f : wrt[k * 64 + (n - 16)])) * nf[k]; const bf16 hi = f2bf(v); wh[i] = hi; wl[i] = f2bf(v - bf2f(hi)); } }
    bf16* xn = (bf16*)P.out; const float* x = P.in[0]; const float* meta = P.in[1]; const float* g = P.in[2]; unsigned char* xn8 = (unsigned char*)P.out + XN8_OFF;
    auto rowsrc = [&](int r) -> const float* { const int b = r / LP, p = r - b * LP; return p < 48 ? nullptr : (p < 64 ? meta + (size_t)(p - 48) * 1024 : x + ((size_t)b * SEQ + (p - 64)) * 1024); };
    f32x4 gv[4];
#pragma unroll
    for (int j = 0; j < 4; ++j) gv[j] = ((const f32x4*)g)[lane + 64 * j];
    f32x4 vn[4], vm[4]; const float* sn = nullptr; const float* sm = nullptr; int r = gw;
    if (r < TP) { sn = rowsrc(r); if (sn) {
#pragma unroll
        for (int j = 0; j < 4; ++j) vn[j] = ((const f32x4*)sn)[lane + 64 * j]; } }
    if (r + NGW < TP) { sm = rowsrc(r + NGW); if (sm) {
#pragma unroll
        for (int j = 0; j < 4; ++j) vm[j] = ((const f32x4*)sm)[lane + 64 * j]; } }
    for (; r < TP; r += NGW) {
        f32x4 v[4]; const float* sc = sn;
#pragma unroll
        for (int j = 0; j < 4; ++j) { v[j] = vn[j]; vn[j] = vm[j]; }
        sn = sm;
        const int rn = r + 2 * NGW; sm = nullptr;
        if (rn < TP) { sm = rowsrc(rn); if (sm) {
#pragma unroll
            for (int j = 0; j < 4; ++j) vm[j] = ((const f32x4*)sm)[lane + 64 * j]; } }
        unsigned long long* o8 = (unsigned long long*)(xn + (size_t)r * 1024) + lane; unsigned* o4 = (unsigned*)(xn8 + (size_t)r * 1024) + lane;
        if (!sc) {
#pragma unroll
            for (int j = 0; j < 4; ++j) { o8[64 * j] = 0ull; o4[64 * j] = 0u; }
            continue; }
        float s = 0.f;
#pragma unroll
        for (int j = 0; j < 4; ++j) s += (v[j][0] * v[j][0] + v[j][1] * v[j][1]) + (v[j][2] * v[j][2] + v[j][3] * v[j][3]);
        const float rs = rsqrtf(wave_sum(s) * (1.f / 1024.f) + EPS);
#pragma unroll
        for (int j = 0; j < 4; ++j) { const f32x4 gg = gv[j];
            o8[64 * j] = (unsigned long long)pk2(v[j][0] * rs * gg[0], v[j][1] * rs * gg[1]) | ((unsigned long long)pk2(v[j][2] * rs * gg[2], v[j][3] * rs * gg[3]) << 32);
            o4[64 * j] = pk4_fp8(v[j][0] * rs * gg[0], v[j][1] * rs * gg[1], v[j][2] * rs * gg[2], v[j][3] * rs * gg[3]); }
    }
}

struct PxItem { const float* src; unsigned char* dst; size_t drow0; int ldw, c0, k0, ldk, hasks; float sc; };
DI PxItem px_decode(const Params& P, int it) {
    constexpr int I13 = 32 * 16, I2 = 32 * 8;
    PxItem x; const int e = it / (I13 + I2); int r = it % (I13 + I2);
    if (r < I13) { const int nb = r >> 4, kb = r & 15, pn = nb >> 3, q = nb & 7; x.src = (q < 4 ? P.in[19] : P.in[20]) + (size_t)e * 1024 * 512; x.ldw = 512; x.c0 = 128 * pn + 32 * (q & 3); x.k0 = 64 * kb;
        x.hasks = 1; x.sc = 32.f; x.dst = P.ws + WS_WEXP13 + (size_t)e * 1024 * 1024; x.drow0 = (size_t)32 * nb; x.ldk = 1024; }
    else { r -= I13; const int nb = r >> 3, kb = r & 7; x.src = P.in[21] + (size_t)e * 512 * 1024; x.ldw = 1024; x.c0 = 32 * nb; x.k0 = 64 * kb;
        x.hasks = 0; x.sc = 16.f; x.dst = P.ws + WS_WEXP2 + (size_t)e * 1024 * 512; x.drow0 = (size_t)32 * nb; x.ldk = 512; }
    return x;
}
DI void px_load(const PxItem& x, const float* nf, f32x4 (&v)[8], float (&ksv)[8], int lane) {
    const int row = lane >> 3, col = x.c0 + ((lane >> 2) & 1) * 16 + 4 * (lane & 3);
#pragma unroll
    for (int i = 0; i < 8; ++i) { v[i] = *(const f32x4*)(x.src + (size_t)(x.k0 + 8 * i + row) * x.ldw + col); ksv[i] = nf[x.k0 + 8 * i + row]; }
}
DI void phase_px(const Params& P, LAS unsigned char* lds, const bool split) {
    int tid_o = threadIdx.x; asm volatile("" : "+v"(tid_o)); const int tid = tid_o, lane = tid & 63, wave = __builtin_amdgcn_readfirstlane(tid >> 6);
    if (split && ((blockIdx.x >> 3) & 1)) return;
    const int gw = split ? (int)(((blockIdx.x & 7) | ((blockIdx.x >> 4) << 3)) * 8 + wave) : (int)(blockIdx.x * 8 + wave), NGW = split ? 1024 : (int)gridDim.x * 8;
    LAS float* scr = (LAS float*)(lds + wave * 8448);
    constexpr int NIT = 64 * (32 * 16 + 32 * 8);
    const float* nf = P.in[14];
    f32x4 va[8], vb[8]; float ka[8], kb[8];
#define PX_PROCESS(v_, k_, it_, nxt_) { \
        { const PxItem cur = px_decode(P, (it_)); const int row = lane >> 3, j0 = ((lane >> 2) & 1) * 16 + 4 * (lane & 3); \
            _Pragma("unroll") for (int i = 0; i < 8; ++i) { LAS float* d = scr + (8 * i + row) * 33 + j0; const float g = cur.hasks ? k_[i] * cur.sc : cur.sc; d[0] = v_[i][0] * g; d[1] = v_[i][1] * g; d[2] = v_[i][2] * g; d[3] = v_[i][3] * g; } } \
        LDS_WAIT(); \
        if ((nxt_) < NIT) { const PxItem nxt = px_decode(P, (nxt_)); px_load(nxt, nf, v_, k_, lane); } \
        { const PxItem cur = px_decode(P, (it_)); const int c = lane & 7; \
            _Pragma("unroll") for (int jj = 0; jj < 4; ++jj) { const int n = (lane >> 3) + 8 * jj; const LAS float* s = scr + (8 * c) * 33 + n; \
                u32x2 o; o.x = pk4_fp8(s[0 * 33], s[1 * 33], s[2 * 33], s[3 * 33]); o.y = pk4_fp8(s[4 * 33], s[5 * 33], s[6 * 33], s[7 * 33]); \
                *(u32x2*)(cur.dst + (cur.drow0 + n) * cur.ldk + cur.k0 + 8 * c) = o; } } \
        LDS_WAIT(); }
    if (gw < NIT) { const PxItem x0 = px_decode(P, gw); px_load(x0, nf, va, ka, lane); }
    if (gw + NGW < NIT) { const PxItem x1 = px_decode(P, gw + NGW); px_load(x1, nf, vb, kb, lane); }
#pragma nounroll
    for (int it = gw; it < NIT; it += 2 * NGW) {
        PX_PROCESS(va, ka, it, it + 2 * NGW)
        if (it + NGW < NIT) PX_PROCESS(vb, kb, it + NGW, it + 3 * NGW)
    }
#undef PX_PROCESS
}

#define MFMA32(a, b, c) __builtin_amdgcn_mfma_f32_32x32x16_bf16((a), (b), (c), 0, 0, 0)
#define MFMA16(a, b, c) __builtin_amdgcn_mfma_f32_16x16x32_bf16((a), (b), (c), 0, 0, 0)
DI bf16x8 lds_rowfrag(const LAS unsigned char* tile, int pitchB, int row, int k0) { return *(const LAS bf16x8*)(tile + row * pitchB + k0 * 2); }
DI bf16x8 lds_colfrag(const LAS unsigned char* tile, int pitchB, int col, int k0) {
    const LAS bf16* p = (const LAS bf16*)(tile + k0 * pitchB) + col; const int ps = pitchB / 2; u32x4 w;
    w.x = (unsigned)p[0] | ((unsigned)p[ps] << 16); w.y = (unsigned)p[2 * ps] | ((unsigned)p[3 * ps] << 16);
    w.z = (unsigned)p[4 * ps] | ((unsigned)p[5 * ps] << 16); w.w = (unsigned)p[6 * ps] | ((unsigned)p[7 * ps] << 16);
    return __builtin_bit_cast(bf16x8, w);
}
constexpr int PD_RAW = 0, PD_AM = 0, PD_QT = 51456, PD_KT = PD_QT + 17408, PD_VT = PD_KT + 17408, PD_SC = PD_VT + 17408, PD_CW = PD_SC + 1536, PD_TD = PD_CW + 6144, PD_UT = PD_TD + 2048, PD_WS = PD_UT + 4 * 4608;
static_assert(PD_WS + 4 * 5120 <= LDS_BYTES - 64, "prep_dn LDS map");
DI bf16x8 packacc(const f32x4& a, const f32x4& b) { u32x4 w; w.x = pk2(a[0], a[1]); w.y = pk2(a[2], a[3]); w.z = pk2(b[0], b[1]); w.w = pk2(b[2], b[3]); return __builtin_bit_cast(bf16x8, w); }
#define MFMAF(a, b, c) __builtin_amdgcn_mfma_f32_16x16x4f32((a), (b), (c), 0, 0, 0)

DI void prep_dn_phase(const Params& P, LAS unsigned char* lds) {
    int tid_o = threadIdx.x; asm volatile("" : "+v"(tid_o)); const int tid = tid_o, lane = tid & 63, wave = __builtin_amdgcn_readfirstlane(tid >> 6);
    const int G = gridDim.x;
    bf16* pdn = (bf16*)(P.ws + WS_PDN); const bf16* halo = (const bf16*)(P.ws + WS_HALO); const float* small = (const float*)(P.ws + WS_SMALL);
    LAS float* SC = (LAS float*)(lds + PD_SC);
    LAS float* AM = (LAS float*)(lds + PD_AM);
    LAS float* CW = (LAS float*)(lds + PD_CW);
    u32x4 pf[7]; f32x4 pfw; float pfa = 0.f, pfb = 0.f;
#define PDN_PREFETCH(it_) do { const int h_ = (it_) & 7, gch_ = (it_) >> 3, c_ = gch_ % NCH, R0_ = gch_ * 64; \
        _Pragma("unroll") for (int q_ = 0; q_ < 7; ++q_) { const int p_ = tid + 512 * q_; pf[q_] = (u32x4){0u, 0u, 0u, 0u}; \
            if (p_ < 3216) { const int row_ = p_ / 48, rem_ = p_ - row_ * 48, seg_ = rem_ >> 4, c16_ = rem_ & 15; \
                if (row_ >= 3) pf[q_] = *(const u32x4*)(pdn + (size_t)(R0_ + row_ - 3) * 3072 + seg_ * 1024 + h_ * 128 + c16_ * 8); \
                else if (c_ > 0) pf[q_] = *(const u32x4*)(halo + ((size_t)(gch_ - 1) * 3 + row_) * 3072 + seg_ * 1024 + h_ * 128 + c16_ * 8); } } \
        if (tid < 384) { const int j_ = tid / 96, r_ = tid - j_ * 96, seg_ = r_ >> 5, c4_ = r_ & 31; pfw = *(const f32x4*)(P.in[4] + j_ * 3072 + seg_ * 1024 + h_ * 128 + c4_ * 4); } \
        if (tid < 64) { pfa = small[(size_t)(R0_ + tid) * 32 + h_]; pfb = small[(size_t)(R0_ + tid) * 32 + 8 + h_]; } } while (0)
    const bool swz = (G == 256);
#define PDN_ITEM(k_) (swz ? ((((k_) * 8 + (blockIdx.x & 7)) * 4 + (blockIdx.x >> 6)) * 8 + ((blockIdx.x >> 3) & 7)) : ((int)blockIdx.x + (k_) * G))
    const int nk = swz ? NIT_DN / 256 : ((int)blockIdx.x < NIT_DN ? (NIT_DN - (int)blockIdx.x + G - 1) / G : 0);
    if (nk > 0) PDN_PREFETCH(PDN_ITEM(0));
#pragma nounroll
    for (int kk = 0; kk < nk; ++kk) { const int item = PDN_ITEM(kk);
        const int h = item & 7, gch = item >> 3, c = gch % NCH; const int R0 = gch * 64;
        unsigned char* ext = P.ws + WS_EXT + (size_t)item * 24576; float* scdn = (float*)(P.ws + WS_SC_DN) + (size_t)item * 80;
#pragma unroll
        for (int q = 0; q < 7; ++q) { const int p = tid + 512 * q; if (p < 3216) { const int row = p / 48, rem = p - row * 48; *(LAS u32x4*)(lds + PD_RAW + row * 768 + rem * 16) = pf[q]; } }
        if (tid < 384) { const int j = tid / 96, r = tid - j * 96; *(LAS f32x4*)(CW + j * 384 + r * 4) = pfw; }
        if (tid < 64) {
            const bool pad = (c == 0 && tid < 48);
            float g = pad ? 0.f : -__expf(P.in[5][h]) * softplusf_(pfa + P.in[6][h]);
            const float beta = pad ? 0.f : sigmoidf_(pfb);
#pragma unroll
            for (int o = 1; o < 64; o <<= 1) { const float t = __shfl_up(g, o); if (lane >= o) g += t; }
            SC[tid] = g; SC[64 + tid] = beta; SC[256 + tid] = __expf(g);
            const float gl = __shfl(g, 63);
            scdn[tid] = __expf(gl - g); if (tid == 0) scdn[64] = __expf(gl);
        }
        __syncthreads();
        if (kk + 1 < nk) PDN_PREFETCH(PDN_ITEM(kk + 1));
#pragma unroll
        for (int rnd = 0; rnd < 3; ++rnd) { const int idx = tid + 512 * rnd; const int rg = idx / 192, cp = idx - rg * 192, tsr = cp >> 6, colp = cp & 63;
            float w0[4], w1[4];
#pragma unroll
            for (int j = 0; j < 4; ++j) { w0[j] = CW[j * 384 + 2 * cp]; w1[j] = CW[j * 384 + 2 * cp + 1]; }
            const LAS unsigned char* rp = lds + PD_RAW + (8 * rg) * 768 + cp * 4;
            float r0[3], r1[3];
#pragma unroll
            for (int j = 0; j < 3; ++j) { const unsigned v = *(const LAS unsigned*)(rp + j * 768); r0[j] = bflo(v); r1[j] = bfhi(v); }
            LAS unsigned char* tile = lds + PD_QT + tsr * 17408;
#pragma unroll
            for (int ii = 0; ii < 8; ++ii) { const unsigned v = *(const LAS unsigned*)(rp + (3 + ii) * 768); const float x0 = bflo(v), x1 = bfhi(v);
                const float o0 = w0[0] * r0[0] + w0[1] * r0[1] + w0[2] * r0[2] + w0[3] * x0, o1 = w1[0] * r1[0] + w1[1] * r1[1] + w1[2] * r1[2] + w1[3] * x1;
                r0[0] = r0[1]; r0[1] = r0[2]; r0[2] = x0; r1[0] = r1[1]; r1[1] = r1[2]; r1[2] = x1;
                *(LAS unsigned*)(tile + (8 * rg + ii) * 272 + 4 * colp) = pk2(siluf_(o0), siluf_(o1)); } }
        __syncthreads();
        { const int i = tid >> 3, part = tid & 7; const LAS unsigned char* qp = lds + PD_QT + i * 272 + part * 32; const LAS unsigned char* kp = lds + PD_KT + i * 272 + part * 32;
            float sq = 0.f, sk = 0.f;
#pragma unroll
            for (int j = 0; j < 2; ++j) { float f[8]; unpack8(*(const LAS u32x4*)(qp + 16 * j), f);
#pragma unroll
                for (int e = 0; e < 8; ++e) sq += f[e] * f[e];
                unpack8(*(const LAS u32x4*)(kp + 16 * j), f);
#pragma unroll
                for (int e = 0; e < 8; ++e) sk += f[e] * f[e]; }
            sq += __shfl_xor(sq, 1); sq += __shfl_xor(sq, 2); sq += __shfl_xor(sq, 4); sk += __shfl_xor(sk, 1); sk += __shfl_xor(sk, 2); sk += __shfl_xor(sk, 4);
            if (part == 0) { SC[128 + i] = rsqrtf(sq + EPS) * 0.08838834764831845f; SC[192 + i] = rsqrtf(sk + EPS); } }
        __syncthreads();
        { const int which = wave >> 2, qd = wave & 3, r = lane & 31, hh = lane >> 5;
            f32x16 acc;
#pragma unroll
            for (int e = 0; e < 16; ++e) acc[e] = 0.f;
            if (which == 0) { const int qi = qd >> 1, qj = qd & 1;
                if (!(qi == 0 && qj == 1)) {
#pragma unroll
                    for (int s = 0; s < 8; ++s) acc = MFMA32(lds_rowfrag(lds + PD_KT, 272, 32 * qi + r, 16 * s + 8 * hh), lds_rowfrag(lds + PD_KT, 272, 32 * qj + r, 16 * s + 8 * hh), acc); }
                const int j = 32 * qj + r; const float gcj = SC[j], rkj = SC[192 + j];
#pragma unroll
                for (int reg = 0; reg < 16; ++reg) { const int i = 32 * qi + (reg & 3) + 8 * (reg >> 2) + 4 * hh;
                    AM[i * 68 + j] = (i > j) ? SC[64 + i] * acc[reg] * SC[192 + i] * rkj * __expf(SC[i] - gcj) : 0.f; }
            } else { const int qj = qd >> 1, qi = qd & 1;
                if (!(qi == 0 && qj == 1)) {
#pragma unroll
                    for (int s = 0; s < 8; ++s) acc = MFMA32(lds_rowfrag(lds + PD_KT, 272, 32 * qj + r, 16 * s + 8 * hh), lds_rowfrag(lds + PD_QT, 272, 32 * qi + r, 16 * s + 8 * hh), acc); }
                const int i = 32 * qi + r; const float gci = SC[i], rqi = SC[128 + i]; bf16* qkg = (bf16*)(ext + 16384);
#pragma unroll
                for (int g4 = 0; g4 < 4; ++g4) { const int j0 = 32 * qj + 8 * g4 + 4 * hh; float v[4];
#pragma unroll
                    for (int e = 0; e < 4; ++e) { const int j = j0 + e; v[e] = (i >= j) ? acc[4 * g4 + e] * rqi * SC[192 + j] * __expf(gci - SC[j]) : 0.f; }
                    u32x2 w; w.x = pk2(v[0], v[1]); w.y = pk2(v[2], v[3]); *(u32x2*)(qkg + i * 64 + j0) = w; } } }
        __syncthreads();
        if (wave != 0)
        for (int p = tid - 64; p < 2048; p += NTHREADS - 64) {
            if (p < 1024) { const int i = p >> 4, d0 = (p & 15) * 8; float f[8]; unpack8(*(const LAS u32x4*)(lds + PD_QT + i * 272 + d0 * 2), f);
                const float sc = SC[128 + i] * SC[256 + i]; f32x4 a = {f[0] * sc, f[1] * sc, f[2] * sc, f[3] * sc}, b = {f[4] * sc, f[5] * sc, f[6] * sc, f[7] * sc};
                *(u32x4*)(pdn + (size_t)(R0 + i) * 3072 + h * 128 + d0) = pack8(a, b); }
            else { const int pp = p - 1024, d = pp >> 3, ig = pp & 7; const LAS bf16* kp = (const LAS bf16*)(lds + PD_KT) + (8 * ig) * 136 + d; float f[8];
#pragma unroll
                for (int e = 0; e < 8; ++e) f[e] = bf2f(kp[e * 136]) * SC[192 + 8 * ig + e];
                f32x4 a = {f[0], f[1], f[2], f[3]}, b = {f[4], f[5], f[6], f[7]};
                *(u32x4*)(pdn + (size_t)(R0 + (d >> 1)) * 3072 + 1024 + h * 128 + (d & 1) * 64 + 8 * ig) = pack8(a, b); }
        }
        if (wave == 0) {
            LAS bf16* TDw = (LAS bf16*)(lds + PD_TD);
            { int vz; asm volatile("v_mov_b32 %0, 0" : "=v"(vz));
                const int blk = lane >> 4, jj = lane & 15; const LAS float* Ab = AM + vz + (16 * blk) * 68 + 16 * blk;
                float t[16]; const float jf = (float)(jj + vz);
#pragma unroll
                for (int i = 0; i < 16; ++i) { float s = 1.f - fminf(fabsf(jf - (float)i), 1.f);
#pragma unroll
                    for (int k4 = 0; k4 < (i + 3) / 4; ++k4) { const f32x4 a = *(const LAS f32x4*)(Ab + i * 68 + 4 * k4);
#pragma unroll
                        for (int cc = 0; cc < 4; ++cc) if (4 * k4 + cc < i) s -= a[cc] * t[4 * k4 + cc]; }
                    t[i] = s; }
#pragma unroll
                for (int i = 0; i < 16; ++i) TDw[(16 * blk + i) * 16 + jj] = f2bf(t[i]); }
        }
        __syncthreads();
        {
            int lane_o = lane; asm volatile("" : "+v"(lane_o)); const int lane = lane_o;
            const LAS bf16* TDw = (const LAS bf16*)(lds + PD_TD);
            const int which = wave >> 2, idx4 = wave & 3, m = lane & 15, kq = lane >> 4;
            bf16x8 Top[4], Aop[4];
#pragma unroll
            for (int bb = 0; bb < 4; ++bb) { const u32x2 lo = *(const LAS u32x2*)(TDw + (16 * bb + m) * 16 + 4 * kq); u32x4 w; w.x = lo.x; w.y = lo.y; w.z = 0u; w.w = 0u; Top[bb] = __builtin_bit_cast(bf16x8, w); }
            { const f32x4 z4 = {0.f, 0.f, 0.f, 0.f};
                const LAS float* r1 = AM + (16 + m) * 68 + 4 * kq; const LAS float* r2 = AM + (32 + m) * 68 + 4 * kq; const LAS float* r3 = AM + (48 + m) * 68 + 4 * kq;
                Aop[0] = packacc(-*(const LAS f32x4*)r1, z4); Aop[1] = packacc(-*(const LAS f32x4*)r2, -*(const LAS f32x4*)(r2 + 16));
                Aop[2] = packacc(-*(const LAS f32x4*)r3, -*(const LAS f32x4*)(r3 + 16)); Aop[3] = packacc(-*(const LAS f32x4*)(r3 + 32), z4); }
            float scv[4][4];
#pragma unroll
            for (int i = 0; i < 4; ++i)
#pragma unroll
                for (int reg = 0; reg < 4; ++reg) { const int row = 16 * i + 4 * kq + reg; scv[i][reg] = which == 0 ? SC[64 + row] : SC[64 + row] * SC[192 + row] * SC[256 + row]; }
            const LAS unsigned char* RT = lds + (which == 0 ? PD_VT : PD_KT);
            LAS bf16* UTw = (LAS bf16*)(lds + PD_UT + idx4 * 4608);
            LAS bf16* WTw = (LAS bf16*)(lds + PD_WS + idx4 * 5120);
            const f32x4 z4 = {0.f, 0.f, 0.f, 0.f};
#pragma unroll
            for (int nt = 0; nt < 2; ++nt) { const int e = 32 * idx4 + 16 * nt + m;
                f32x4 Bv[4];
#pragma unroll
                for (int i = 0; i < 4; ++i)
#pragma unroll
                    for (int reg = 0; reg < 4; ++reg) Bv[i][reg] = bf2f(*(const LAS bf16*)(RT + (16 * i + 4 * kq + reg) * 272 + e * 2)) * scv[i][reg];
                f32x4 U[4];
                U[0] = MFMA16(Top[0], packacc(Bv[0], z4), z4);
                { const f32x4 R = MFMA16(Aop[0], packacc(U[0], z4), Bv[1]); U[1] = MFMA16(Top[1], packacc(R, z4), z4); }
                { const f32x4 R = MFMA16(Aop[1], packacc(U[0], U[1]), Bv[2]); U[2] = MFMA16(Top[2], packacc(R, z4), z4); }
                { f32x4 R = MFMA16(Aop[2], packacc(U[0], U[1]), Bv[3]); R = MFMA16(Aop[3], packacc(U[2], z4), R); U[3] = MFMA16(Top[3], packacc(R, z4), z4); }
                if (which == 0) {
#pragma unroll
                    for (int i = 0; i < 4; ++i) { u32x2 w; w.x = pk2(U[i][0], U[i][1]); w.y = pk2(U[i][2], U[i][3]); *(LAS u32x2*)(UTw + (16 * nt + m) * 72 + 16 * i + 4 * kq) = w; }
                } else {
#pragma unroll
                    for (int i = 0; i < 4; ++i)
#pragma unroll
                        for (int reg = 0; reg < 4; ++reg) WTw[(16 * i + 4 * kq + reg) * 40 + 16 * nt + m] = f2bf(-U[i][reg]);
                } }
            if (which == 0) { LDS_WAIT();
#pragma unroll
                for (int it4 = 0; it4 < 4; ++it4) { const int rl = 8 * it4 + (lane >> 3), pc = lane & 7, e = 32 * idx4 + rl;
                    *(u32x4*)(pdn + (size_t)(R0 + (e >> 1)) * 3072 + 2048 + h * 128 + (e & 1) * 64 + 8 * pc) = *(const LAS u32x4*)(UTw + rl * 72 + 8 * pc); } }
            if (which == 1) { LDS_WAIT(); bf16* wn = (bf16*)ext;
#pragma unroll
                for (int it4 = 0; it4 < 4; ++it4) { const int cc = 16 * it4 + (lane >> 2), pc = lane & 3;
                    *(u32x4*)(wn + cc * 128 + 32 * idx4 + 8 * pc) = *(const LAS u32x4*)(WTw + cc * 40 + 8 * pc); } }
        }
        __syncthreads();
    }
#undef PDN_PREFETCH
#undef PDN_ITEM
}

constexpr int WLDS = 20480;
DI void prep_gla_wave(const Params& P, LAS unsigned char* wl, int item, int lane) {
    const int h = item & 3, gch = item >> 2, c = gch % NCH; const int R0 = gch * 64;
    bf16* pg = (bf16*)(P.ws + WS_PGLA); const float* small = (const float*)(P.ws + WS_SMALL);
    const int d0 = 2 * lane;
    f32x2_t wa[16];
#pragma unroll
    for (int r = 0; r < 16; ++r) wa[r] = *(const f32x2_t*)(P.in[9] + r * 512 + h * 128 + d0);
    const f32x2_t ba = *(const f32x2_t*)(P.in[10] + h * 128 + d0);
    float b0 = 0.f, b1 = 0.f;
    bf16* qrow = pg + (size_t)R0 * 2048 + h * 128 + d0;
    bf16* kt0 = pg + (size_t)(R0 + lane) * 2048 + 512 + h * 128;
    f32x4 lrv[4];
#pragma unroll
    for (int q = 0; q < 4; ++q) lrv[q] = *(const f32x4*)(small + (size_t)(R0 + lane) * 32 + 16 + 4 * q);
    int vz; asm volatile("v_mov_b32 %0, 0" : "=v"(vz));
    const LAS float* LRB = (const LAS float*)(wl + 17408) + vz;
#pragma unroll
    for (int i8 = 0; i8 < 8; ++i8) {
        unsigned qv[8], kv[8];
#pragma unroll
        for (int e = 0; e < 8; ++e) { const bf16* p = qrow + (size_t)(8 * i8 + e) * 2048; qv[e] = *(const unsigned*)p; kv[e] = *(const unsigned*)(p + 512); }
        if ((lane >> 3) == i8) {
#pragma unroll
            for (int q = 0; q < 4; ++q) *(LAS f32x4*)((LAS float*)(wl + 17408) + (lane & 7) * 16 + 4 * q) = lrv[q]; }
        asm volatile("" ::: "memory");
        float ka0[8], ka1[8];
#pragma unroll
        for (int e = 0; e < 8; ++e) { const int i = 8 * i8 + e;
            f32x2_t xx = ba;
#pragma unroll
            for (int r4 = 0; r4 < 4; ++r4) { const f32x4 l = *(const LAS f32x4*)(LRB + e * 16 + 4 * r4);
#pragma unroll
                for (int rr = 0; rr < 4; ++rr) { const f32x2_t lb = {l[rr], l[rr]}; xx = __builtin_elementwise_fma(lb, wa[4 * r4 + rr], xx); } }
            const float x0 = xx[0], x1 = xx[1];
            const bool pad = (c == 0 && i < 48);
            b0 += pad ? 0.f : logsigmoidf_(x0) * (1.f / 16.f); b1 += pad ? 0.f : logsigmoidf_(x1) * (1.f / 16.f);
            const float E0 = __expf(b0), E1 = __expf(b1), I0 = __builtin_amdgcn_rcpf(E0), I1 = __builtin_amdgcn_rcpf(E1);
            const unsigned q = pk2(bflo(qv[e]) * 0.08838834764831845f * E0, bfhi(qv[e]) * 0.08838834764831845f * E1);
            *(unsigned*)(qrow + (size_t)i * 2048) = q;
            ka0[e] = bflo(kv[e]) * I0; ka1[e] = bfhi(kv[e]) * I1;
            *(LAS unsigned*)(wl + i * 272 + 4 * lane) = pk2(ka0[e], ka1[e]); }
    }
    asm volatile("" ::: "memory");
#pragma unroll
    for (int i8 = 0; i8 < 8; ++i8) { unsigned v[8];
#pragma unroll
        for (int e = 0; e < 8; ++e) v[e] = *(const LAS unsigned*)(wl + (8 * i8 + e) * 272 + 4 * lane);
        u32x4 w0, w1;
        w0.x = (v[0] & 0xffffu) | (v[1] << 16); w0.y = (v[2] & 0xffffu) | (v[3] << 16); w0.z = (v[4] & 0xffffu) | (v[5] << 16); w0.w = (v[6] & 0xffffu) | (v[7] << 16);
        w1.x = (v[0] >> 16) | (v[1] & 0xffff0000u); w1.y = (v[2] >> 16) | (v[3] & 0xffff0000u); w1.z = (v[4] >> 16) | (v[5] & 0xffff0000u); w1.w = (v[6] >> 16) | (v[7] & 0xffff0000u);
        *(u32x4*)(kt0 + 8 * i8) = w0; *(u32x4*)(kt0 + 64 + 8 * i8) = w1; }
    { f32x2_t eb = {__expf(b0), __expf(b1)}; *(f32x2_t*)((float*)(P.ws + WS_EBL) + (size_t)item * 128 + d0) = eb; }
    const int r = lane & 31, hh = lane >> 5;
    bf16x8 kf[2][8];
#pragma unroll
    for (int qj = 0; qj < 2; ++qj)
#pragma unroll
        for (int s = 0; s < 8; ++s) kf[qj][s] = lds_rowfrag(wl, 272, 32 * qj + r, 16 * s + 8 * hh);
    asm volatile("s_waitcnt vmcnt(0)" ::: "memory");
#pragma unroll
    for (int i16 = 0; i16 < 4; ++i16) { unsigned qq[16];
#pragma unroll
        for (int e = 0; e < 16; ++e) qq[e] = __hip_atomic_load((const unsigned*)(qrow + (size_t)(16 * i16 + e) * 2048), __ATOMIC_RELAXED, __HIP_MEMORY_SCOPE_AGENT);
#pragma unroll
        for (int e = 0; e < 16; ++e) *(LAS unsigned*)(wl + (16 * i16 + e) * 272 + 4 * lane) = qq[e]; }
    bf16* att = (bf16*)(P.ws + WS_ATT + (size_t)item * 8192);
#pragma unroll
    for (int qd3 = 0; qd3 < 3; ++qd3) { const int qj = qd3 >> 1, qi = (qd3 + 1) >> 1;
        f32x16 acc;
#pragma unroll
        for (int e = 0; e < 16; ++e) acc[e] = 0.f;
#pragma unroll
        for (int s = 0; s < 8; ++s) acc = MFMA32(kf[qj][s], lds_rowfrag(wl, 272, 32 * qi + r, 16 * s + 8 * hh), acc);
        const int i = 32 * qi + r;
#pragma unroll
        for (int g4 = 0; g4 < 4; ++g4) { const int j0 = 32 * qj + 8 * g4 + 4 * hh; float v[4];
#pragma unroll
            for (int e = 0; e < 4; ++e) v[e] = (i >= j0 + e) ? acc[4 * g4 + e] : 0.f;
            u32x2 w; w.x = pk2(v[0], v[1]); w.y = pk2(v[2], v[3]); *(u32x2*)(att + i * 64 + j0) = w; } }
#pragma unroll
    for (int g4 = 0; g4 < 4; ++g4) { u32x2 z = {0u, 0u}; *(u32x2*)(att + r * 64 + 32 + 8 * g4 + 4 * hh) = z; }
    asm volatile("" ::: "memory");
}
DI void prep_gla_phase(const Params& P, LAS unsigned char* lds) {
    int tid_o = threadIdx.x; asm volatile("" : "+v"(tid_o)); const int tid = tid_o, lane = tid & 63, wave = __builtin_amdgcn_readfirstlane(tid >> 6);
    LAS unsigned char* wl = lds + wave * WLDS;
    for (int item = blockIdx.x + gridDim.x * wave; item < NIT_GLA; item += gridDim.x * 8) prep_gla_wave(P, wl, item, lane);
}

DI bf16x8 frag2(const LAS unsigned char* tile, int pitchB, int row, int c0) {
    const u32x2 lo = *(const LAS u32x2*)(tile + row * pitchB + c0 * 2), hi = *(const LAS u32x2*)(tile + row * pitchB + (c0 + 16) * 2);
    u32x4 w; w.x = lo.x; w.y = lo.y; w.z = hi.x; w.w = hi.y; return __builtin_bit_cast(bf16x8, w);
}
constexpr int SC_WN = 0, SC_QD = 17408, SC_QK = 34816, SC_KT = 44032, SC_BUF = 62464, SC_DK = 124928, SC_SSQ = 125952;

DI bf16x8 frag32(const LAS unsigned char* tile, int pitchB, int row, int k0, int hh) {
    const u32x2 lo = *(const LAS u32x2*)(tile + row * pitchB + (k0 + 4 * hh) * 2), hi = *(const LAS u32x2*)(tile + row * pitchB + (k0 + 8 + 4 * hh) * 2);
    u32x4 w; w.x = lo.x; w.y = lo.y; w.z = hi.x; w.w = hi.y; return __builtin_bit_cast(bf16x8, w);
}
DI bf16x8 packacc8(const f32x16& x, int h2) { u32x4 w; w.x = pk2(x[8 * h2], x[8 * h2 + 1]); w.y = pk2(x[8 * h2 + 2], x[8 * h2 + 3]); w.z = pk2(x[8 * h2 + 4], x[8 * h2 + 5]); w.w = pk2(x[8 * h2 + 6], x[8 * h2 + 7]); return __builtin_bit_cast(bf16x8, w); }

#define SBAR() asm volatile("s_waitcnt lgkmcnt(0)\n\ts_barrier" ::: "memory")
DI void scan_dn_item(const Params& P, LAS unsigned char* lds, int item) {
    int tid_o = threadIdx.x; asm volatile("" : "+v"(tid_o)); const int tid = tid_o, lane = tid & 63, wave = __builtin_amdgcn_readfirstlane(tid >> 6);
    const int b = item >> 3, h = item & 7, r = lane & 31, hh = lane >> 5, e0 = 32 * (wave & 3);
    const bool comp = wave < 4; const int lt = tid - 256;
    bf16* pdn = (bf16*)(P.ws + WS_PDN); float* ssqg = (float*)(P.ws + WS_SSQ_DN);
#define SDN_LOAD(cc, st, stdk) do { const int gch_ = b * NCH + (cc); const int R0_ = gch_ * 64; const unsigned char* ext_ = P.ws + WS_EXT + (size_t)(gch_ * 8 + h) * 24576; \
        _Pragma("unroll") for (int j_ = 0; j_ < 4; ++j_) { const int p_ = lt + 256 * j_; st[j_] = *(const u32x4*)(ext_ + (size_t)p_ * 16); \
            st[4 + j_] = *(const u32x4*)(pdn + (size_t)(R0_ + (p_ >> 4)) * 3072 + h * 128 + (p_ & 15) * 8); \
            const int d_ = p_ >> 3; st[10 + j_] = *(const u32x4*)(pdn + (size_t)(R0_ + (d_ >> 1)) * 3072 + 1024 + h * 128 + (d_ & 1) * 64 + (p_ & 7) * 8); } \
        _Pragma("unroll") for (int j_ = 0; j_ < 2; ++j_) { const int p_ = lt + 256 * j_; st[8 + j_] = *(const u32x4*)(ext_ + 16384 + (size_t)p_ * 16); } \
        if (lt < 20) stdk = *(const u32x4*)((const float*)(P.ws + WS_SC_DN) + (size_t)(gch_ * 8 + h) * 80 + lt * 4); } while (0)
#define SDN_STORE(bb, st, stdk) do { LAS unsigned char* B_ = lds + (bb) * SC_BUF; \
        _Pragma("unroll") for (int j_ = 0; j_ < 4; ++j_) { const int p_ = lt + 256 * j_; *(LAS u32x4*)(B_ + SC_WN + (p_ >> 4) * 272 + (p_ & 15) * 16) = st[j_]; *(LAS u32x4*)(B_ + SC_QD + (p_ >> 4) * 272 + (p_ & 15) * 16) = st[4 + j_]; \
            *(LAS u32x4*)(B_ + SC_KT + (p_ >> 3) * 144 + (p_ & 7) * 16) = st[10 + j_]; } \
        _Pragma("unroll") for (int j_ = 0; j_ < 2; ++j_) { const int p_ = lt + 256 * j_; *(LAS u32x4*)(B_ + SC_QK + (p_ >> 3) * 144 + (p_ & 7) * 16) = st[8 + j_]; } \
        if (lt < 20) *(LAS u32x4*)(lds + SC_DK + (bb) * 512 + lt * 16) = stdk; } while (0)
#define SDN_ULOAD(cc) do { const int R0_ = (b * NCH + (cc)) * 64; const int e_ = e0 + r; \
        _Pragma("unroll") for (int q_ = 0; q_ < 8; ++q_) su[q_] = *(const u32x2*)(pdn + (size_t)(R0_ + (e_ >> 1)) * 3072 + 2048 + h * 128 + (e_ & 1) * 64 + 32 * (q_ >> 2) + 8 * (q_ & 3) + 4 * hh); } while (0)
    if (!comp) {
        u32x4 sa[14], sb[14], sc[14]; u32x4 da, db, dc;
        SDN_LOAD(0, sa, da); SDN_STORE(0, sa, da);
        SDN_LOAD(1, sb, db); SDN_LOAD(2, sc, dc);
        SBAR();
#define SDN_STEP(i, SL, DL, SS, DS) do { const int bb_ = (i) & 1; const int R0_s = (b * NCH + (i)) * 64; \
            if ((i) > 0 && lt < 64) { const LAS float* sp = (const LAS float*)(lds + SC_SSQ + (bb_ ^ 1) * 2048); ssqg[(size_t)(R0_s - 64 + lt) * 8 + h] = (sp[lt] + sp[64 + lt]) + (sp[128 + lt] + sp[192 + lt]); } \
            if ((i) + 3 < NCH) SDN_LOAD((i) + 3, SL, DL); \
            if ((i) + 1 < NCH) SDN_STORE(bb_ ^ 1, SS, DS); \
            SBAR(); } while (0)
        for (int c3 = 0; c3 < NCH; c3 += 3) { SDN_STEP(c3, sa, da, sb, db); SDN_STEP(c3 + 1, sb, db, sc, dc); SDN_STEP(c3 + 2, sc, dc, sa, da); }
#undef SDN_STEP
        if (lt < 64) { const LAS float* sp = (const LAS float*)(lds + SC_SSQ + ((NCH - 1) & 1) * 2048); ssqg[(size_t)((b * NCH + NCH - 1) * 64 + lt) * 8 + h] = (sp[lt] + sp[64 + lt]) + (sp[128 + lt] + sp[192 + lt]); }
        SBAR();
    } else {
        f32x16 S[4];
#pragma unroll
        for (int i = 0; i < 4; ++i)
#pragma unroll
            for (int e = 0; e < 16; ++e) S[i][e] = 0.f;
        u32x2 su[8], ucur[8], unx[8];
        SDN_ULOAD(0);
#pragma unroll
        for (int q = 0; q < 8; ++q) ucur[q] = su[q];
        SDN_ULOAD(1);
#pragma unroll
        for (int q = 0; q < 8; ++q) unx[q] = su[q];
        SBAR();
        for (int c = 0; c < NCH; ++c) {
            const int bb = c & 1; const LAS unsigned char* B = lds + bb * SC_BUF; const LAS float* DK = (const LAS float*)(lds + SC_DK + bb * 512);
            const int R0 = (b * NCH + c) * 64;
            if (c + 2 < NCH) SDN_ULOAD(c + 2);
            f32x16 vn[2], oT[2];
#pragma unroll
            for (int mi = 0; mi < 2; ++mi)
#pragma unroll
                for (int g4 = 0; g4 < 4; ++g4) { const u32x2 u = ucur[4 * mi + g4]; vn[mi][4 * g4] = bflo(u.x); vn[mi][4 * g4 + 1] = bfhi(u.x); vn[mi][4 * g4 + 2] = bflo(u.y); vn[mi][4 * g4 + 3] = bfhi(u.y);
                    oT[mi][4 * g4] = 0.f; oT[mi][4 * g4 + 1] = 0.f; oT[mi][4 * g4 + 2] = 0.f; oT[mi][4 * g4 + 3] = 0.f; }
            bf16x8 fw[2][2], fq[2][2];
#pragma unroll
            for (int mi = 0; mi < 2; ++mi) { fw[0][mi] = frag32(B + SC_WN, 272, 32 * mi + r, 0, hh); fq[0][mi] = frag32(B + SC_QD, 272, 32 * mi + r, 0, hh); }
#pragma unroll
            for (int s = 0; s < 8; ++s) { const int cu = s & 1, nx = cu ^ 1;
                if (s < 7) {
#pragma unroll
                    for (int mi = 0; mi < 2; ++mi) { fw[nx][mi] = frag32(B + SC_WN, 272, 32 * mi + r, 16 * (s + 1), hh); fq[nx][mi] = frag32(B + SC_QD, 272, 32 * mi + r, 16 * (s + 1), hh); } }
                const bf16x8 Sf = packacc8(S[s >> 1], s & 1);
                __builtin_amdgcn_sched_barrier(0);
#pragma unroll
                for (int mi = 0; mi < 2; ++mi) { vn[mi] = MFMA32(fw[cu][mi], Sf, vn[mi]); oT[mi] = MFMA32(Sf, fq[cu][mi], oT[mi]); }
                __builtin_amdgcn_sched_barrier(0); }
            bf16x8 fk[4][2];
#pragma unroll
            for (int t = 0; t < 4; ++t)
#pragma unroll
                for (int ni = 0; ni < 2; ++ni) fk[t][ni] = frag32(B + SC_QK, 144, 32 * ni + r, 16 * t, hh);
            bf16x8 vb[4], vd[4];
#pragma unroll
            for (int t = 0; t < 4; ++t) { const int mi = t >> 1, h2 = t & 1; vb[t] = packacc8(vn[mi], h2);
                const f32x4 d0 = *(const LAS f32x4*)(DK + 32 * mi + 16 * h2 + 4 * hh), d1 = *(const LAS f32x4*)(DK + 32 * mi + 16 * h2 + 8 + 4 * hh);
                u32x4 w; w.x = pk2(vn[mi][8 * h2] * d0[0], vn[mi][8 * h2 + 1] * d0[1]); w.y = pk2(vn[mi][8 * h2 + 2] * d0[2], vn[mi][8 * h2 + 3] * d0[3]);
                w.z = pk2(vn[mi][8 * h2 + 4] * d1[0], vn[mi][8 * h2 + 5] * d1[1]); w.w = pk2(vn[mi][8 * h2 + 6] * d1[2], vn[mi][8 * h2 + 7] * d1[3]); vd[t] = __builtin_bit_cast(bf16x8, w); }
            const float egl = DK[64];
            bf16x8 ft[2][4];
#pragma unroll
            for (int t = 0; t < 4; ++t) ft[0][t] = frag32(B + SC_KT, 144, r, 16 * t, hh);
            __builtin_amdgcn_sched_barrier(0);
#pragma unroll
            for (int t = 0; t < 4; ++t)
#pragma unroll
                for (int ni = 0; ni < 2; ++ni) oT[ni] = MFMA32(vb[t], fk[t][ni], oT[ni]);
            __builtin_amdgcn_sched_barrier(0);
#pragma unroll
            for (int db = 0; db < 4; ++db) { const int cu = db & 1, nx = cu ^ 1;
                if (db < 3) {
#pragma unroll
                    for (int t = 0; t < 4; ++t) ft[nx][t] = frag32(B + SC_KT, 144, 32 * (db + 1) + r, 16 * t, hh); }
                S[db] = S[db] * egl;
                __builtin_amdgcn_sched_barrier(0);
#pragma unroll
                for (int t = 0; t < 4; ++t) S[db] = MFMA32(ft[cu][t], vd[t], S[db]);
                __builtin_amdgcn_sched_barrier(0); }
            LAS float* sq = (LAS float*)(lds + SC_SSQ + bb * 2048);
#pragma unroll
            for (int ni = 0; ni < 2; ++ni) { float s = 0.f;
#pragma unroll
                for (int g4 = 0; g4 < 4; ++g4) { u32x2 w; w.x = pk2(oT[ni][4 * g4], oT[ni][4 * g4 + 1]); w.y = pk2(oT[ni][4 * g4 + 2], oT[ni][4 * g4 + 3]);
                    *(u32x2*)(pdn + (size_t)(R0 + 32 * ni + r) * 3072 + h * 128 + e0 + 8 * g4 + 4 * hh) = w;
                    s += (oT[ni][4 * g4] * oT[ni][4 * g4] + oT[ni][4 * g4 + 1] * oT[ni][4 * g4 + 1]) + (oT[ni][4 * g4 + 2] * oT[ni][4 * g4 + 2] + oT[ni][4 * g4 + 3] * oT[ni][4 * g4 + 3]); }
                s += __shfl_xor(s, 32);
                if (hh == 0) sq[wave * 64 + 32 * ni + r] = s; }
#pragma unroll
            for (int q = 0; q < 8; ++q) { ucur[q] = unx[q]; unx[q] = su[q]; }
            SBAR();
        }
        SBAR();
    }
#undef SDN_LOAD
#undef SDN_STORE
#undef SDN_ULOAD
}

constexpr int SG_QD = 0, SG_ATT = 17408, SG_KT = 26624, SG_V = 45056;
DI void scan_gla_item(const Params& P, LAS unsigned char* lds, int item) {
    int tid_o = threadIdx.x; asm volatile("" : "+v"(tid_o)); const int tid = tid_o, lane = tid & 63, wave = __builtin_amdgcn_readfirstlane(tid >> 6);
    const int half = item & 1, h = (item >> 1) & 3, b = item >> 3, r = lane & 31, hh = lane >> 5, e0 = 32 * (wave & 3);
    const bool comp = wave < 4; const int lt = tid - 256;
    bf16* pg = (bf16*)(P.ws + WS_PGLA); float* ssqg = (float*)(P.ws + WS_SSQ_GLA);
    const int vcol = 1024 + h * 256 + half * 128;
#define SGL_LOAD(cc, st, ste) do { const int gch_ = b * NCH + (cc); const int R0_ = gch_ * 64; const int it_ = gch_ * 4 + h; \
        _Pragma("unroll") for (int j_ = 0; j_ < 4; ++j_) { const int p_ = lt + 256 * j_; st[j_] = *(const u32x4*)(pg + (size_t)(R0_ + (p_ >> 4)) * 2048 + h * 128 + (p_ & 15) * 8); \
            const int d_ = p_ >> 3; st[4 + j_] = *(const u32x4*)(pg + (size_t)(R0_ + (d_ >> 1)) * 2048 + 512 + h * 128 + (d_ & 1) * 64 + (p_ & 7) * 8); \
            st[8 + j_] = *(const u32x4*)(pg + (size_t)(R0_ + (p_ >> 4)) * 2048 + vcol + (p_ & 15) * 8); } \
        _Pragma("unroll") for (int j_ = 0; j_ < 2; ++j_) { const int p_ = lt + 256 * j_; st[12 + j_] = *(const u32x4*)(P.ws + WS_ATT + (size_t)it_ * 8192 + (size_t)p_ * 16); } \
        if (lt < 32) ste = *(const u32x4*)((const float*)(P.ws + WS_EBL) + (size_t)it_ * 128 + lt * 4); } while (0)
#define SGL_STORE(bb, st, ste) do { LAS unsigned char* B_ = lds + (bb) * SC_BUF; \
        _Pragma("unroll") for (int j_ = 0; j_ < 4; ++j_) { const int p_ = lt + 256 * j_; *(LAS u32x4*)(B_ + SG_QD + (p_ >> 4) * 272 + (p_ & 15) * 16) = st[j_]; \
            *(LAS u32x4*)(B_ + SG_KT + (p_ >> 3) * 144 + (p_ & 7) * 16) = st[4 + j_]; *(LAS u32x4*)(B_ + SG_V + (p_ >> 4) * 272 + (p_ & 15) * 16) = st[8 + j_]; } \
        _Pragma("unroll") for (int j_ = 0; j_ < 2; ++j_) { const int p_ = lt + 256 * j_; *(LAS u32x4*)(B_ + SG_ATT + (p_ >> 3) * 144 + (p_ & 7) * 16) = st[12 + j_]; } \
        if (lt < 32) *(LAS u32x4*)(lds + SC_DK + (bb) * 512 + lt * 16) = ste; } while (0)
    if (!comp) {
        u32x4 sa[14], sb[14], sc[14]; u32x4 da, db, dc;
        SGL_LOAD(0, sa, da); SGL_STORE(0, sa, da);
        SGL_LOAD(1, sb, db); SGL_LOAD(2, sc, dc);
        SBAR();
#define SGL_STEP(i, SL, DL, SS, DS) do { const int bb_ = (i) & 1; const int R0_s = (b * NCH + (i)) * 64; \
            if ((i) > 0 && lt < 64) { const LAS float* sp = (const LAS float*)(lds + SC_SSQ + (bb_ ^ 1) * 2048); ssqg[(size_t)(R0_s - 64 + lt) * 8 + h * 2 + half] = (sp[lt] + sp[64 + lt]) + (sp[128 + lt] + sp[192 + lt]); } \
            if ((i) + 3 < NCH) SGL_LOAD((i) + 3, SL, DL); \
            if ((i) + 1 < NCH) SGL_STORE(bb_ ^ 1, SS, DS); \
            SBAR(); } while (0)
        for (int c3 = 0; c3 < NCH; c3 += 3) { SGL_STEP(c3, sa, da, sb, db); SGL_STEP(c3 + 1, sb, db, sc, dc); SGL_STEP(c3 + 2, sc, dc, sa, da); }
#undef SGL_STEP
        if (lt < 64) { const LAS float* sp = (const LAS float*)(lds + SC_SSQ + ((NCH - 1) & 1) * 2048); ssqg[(size_t)((b * NCH + NCH - 1) * 64 + lt) * 8 + h * 2 + half] = (sp[lt] + sp[64 + lt]) + (sp[128 + lt] + sp[192 + lt]); }
        SBAR();
    } else {
        f32x16 S[4];
#pragma unroll
        for (int i = 0; i < 4; ++i)
#pragma unroll
            for (int e = 0; e < 16; ++e) S[i][e] = 0.f;
        SBAR();
        for (int c = 0; c < NCH; ++c) {
            const int bb = c & 1; const LAS unsigned char* B = lds + bb * SC_BUF; const LAS float* EB = (const LAS float*)(lds + SC_DK + bb * 512);
            const int R0 = (b * NCH + c) * 64;
            f32x16 oT[2];
#pragma unroll
            for (int ni = 0; ni < 2; ++ni)
#pragma unroll
                for (int e = 0; e < 16; ++e) oT[ni][e] = 0.f;
            bf16x8 fq[2][2];
#pragma unroll
            for (int ni = 0; ni < 2; ++ni) fq[0][ni] = frag32(B + SG_QD, 272, 32 * ni + r, 0, hh);
            bf16x8 vf[4], fk[4][2];
#pragma unroll
            for (int t = 0; t < 4; ++t) { const LAS bf16* vp = (const LAS bf16*)(B + SG_V) + (16 * t + 4 * hh) * 136 + e0 + r; u32x4 w;
                w.x = (unsigned)vp[0] | ((unsigned)vp[136] << 16); w.y = (unsigned)vp[2 * 136] | ((unsigned)vp[3 * 136] << 16);
                w.z = (unsigned)vp[8 * 136] | ((unsigned)vp[9 * 136] << 16); w.w = (unsigned)vp[10 * 136] | ((unsigned)vp[11 * 136] << 16);
                vf[t] = __builtin_bit_cast(bf16x8, w); }
#pragma unroll
            for (int s = 0; s < 8; ++s) { const int cu = s & 1, nx = cu ^ 1;
                if (s < 7) {
#pragma unroll
                    for (int ni = 0; ni < 2; ++ni) fq[nx][ni] = frag32(B + SG_QD, 272, 32 * ni + r, 16 * (s + 1), hh); }
                const bf16x8 Sf = packacc8(S[s >> 1], s & 1);
                __builtin_amdgcn_sched_barrier(0);
#pragma unroll
                for (int ni = 0; ni < 2; ++ni) oT[ni] = MFMA32(Sf, fq[cu][ni], oT[ni]);
                __builtin_amdgcn_sched_barrier(0); }
#pragma unroll
            for (int t = 0; t < 4; ++t)
#pragma unroll
                for (int ni = 0; ni < 2; ++ni) fk[t][ni] = frag32(B + SG_ATT, 144, 32 * ni + r, 16 * t, hh);
            bf16x8 ft[2][4];
#pragma unroll
            for (int t = 0; t < 4; ++t) ft[0][t] = frag32(B + SG_KT, 144, r, 16 * t, hh);
            __builtin_amdgcn_sched_barrier(0);
#pragma unroll
            for (int t = 0; t < 4; ++t)
#pragma unroll
                for (int ni = 0; ni < 2; ++ni) oT[ni] = MFMA32(vf[t], fk[t][ni], oT[ni]);
            __builtin_amdgcn_sched_barrier(0);
#pragma unroll
            for (int db = 0; db < 4; ++db) { const int cu = db & 1, nx = cu ^ 1;
                if (db < 3) {
#pragma unroll
                    for (int t = 0; t < 4; ++t) ft[nx][t] = frag32(B + SG_KT, 144, 32 * (db + 1) + r, 16 * t, hh); }
                __builtin_amdgcn_sched_barrier(0);
#pragma unroll
                for (int t = 0; t < 4; ++t) S[db] = MFMA32(ft[cu][t], vf[t], S[db]);
                __builtin_amdgcn_sched_barrier(0);
#pragma unroll
                for (int g4 = 0; g4 < 4; ++g4) { const f32x4 eb = *(const LAS f32x4*)(EB + 32 * db + 8 * g4 + 4 * hh);
                    S[db][4 * g4] *= eb[0]; S[db][4 * g4 + 1] *= eb[1]; S[db][4 * g4 + 2] *= eb[2]; S[db][4 * g4 + 3] *= eb[3]; } }
            LAS float* sq = (LAS float*)(lds + SC_SSQ + bb * 2048);
#pragma unroll
            for (int ni = 0; ni < 2; ++ni) { float s = 0.f;
#pragma unroll
                for (int g4 = 0; g4 < 4; ++g4) { u32x2 w; w.x = pk2(oT[ni][4 * g4], oT[ni][4 * g4 + 1]); w.y = pk2(oT[ni][4 * g4 + 2], oT[ni][4 * g4 + 3]);
                    *(u32x2*)(pg + (size_t)(R0 + 32 * ni + r) * 2048 + vcol + e0 + 8 * g4 + 4 * hh) = w;
                    s += (oT[ni][4 * g4] * oT[ni][4 * g4] + oT[ni][4 * g4 + 1] * oT[ni][4 * g4 + 1]) + (oT[ni][4 * g4 + 2] * oT[ni][4 * g4 + 2] + oT[ni][4 * g4 + 3] * oT[ni][4 * g4 + 3]); }
                s += __shfl_xor(s, 32);
                if (hh == 0) sq[wave * 64 + 32 * ni + r] = s; }
            SBAR();
        }
        SBAR();
    }
#undef SGL_LOAD
#undef SGL_STORE
}

constexpr int RT_WR = 0, RT_WBUF = 43520, RT_LG = 87040, RT_RS = 128000, RT_HS = 128512;
DI void router_group(const Params& P, LAS unsigned char* lds, int rg) {
    int tid_o = threadIdx.x; asm volatile("" : "+v"(tid_o)); const int tid = tid_o, lane = tid & 63, wave = __builtin_amdgcn_readfirstlane(tid >> 6);
    const unsigned char* wsrc = P.ws + WS_WRT; unsigned char* xb8 = P.ws + WS_XB;
    LAS float* LG = (LAS float*)(lds + RT_LG); LAS float* RS = (LAS float*)(lds + RT_RS); LAS int* HS = (LAS int*)(lds + RT_HS);
    const int i = lane & 15, kq = lane >> 4; const int row = rg * 128 + wave * 16 + i;
    const bf16* hhi = H1HI((const bf16*)(P.ws + WS_PGLA), row) + 8 * kq; const bf16* hlo = (const bf16*)P.out + (size_t)row * 1024 + 8 * kq;
    if (tid < 64) HS[tid] = 0;
    LAS float* BI = (LAS float*)(lds + RT_HS + 256);
    if (tid >= 64 && tid < 136) BI[tid - 64] = (tid < 72) ? P.in[16][tid - 64] : P.in[18][tid - 72];
    f32x4 acc[5];
#pragma unroll
    for (int cb = 0; cb < 5; ++cb) acc[cb] = (f32x4){0.f, 0.f, 0.f, 0.f};
    float ssq = 0.f;
    u32x4 wst[5]; u32x4 aA[8], aB[8];
    int soff[5], doff[5];
#pragma unroll
    for (int q = 0; q < 5; ++q) { const int p = tid + 512 * q, hl = p / 1280, rem = p - hl * 1280, n = rem >> 4, c16 = rem & 15; soff[q] = (hl * 80 + n) * 2048 + c16 * 16; doff[q] = (hl * 80 + n) * 272 + c16 * 16; }
#pragma unroll
    for (int q = 0; q < 5; ++q) wst[q] = *(const u32x4*)(wsrc + soff[q]);
#pragma unroll
    for (int t = 0; t < 8; ++t) aA[t] = *(const u32x4*)(((t & 1) ? hlo : hhi) + 32 * (t >> 1));
#pragma unroll
    for (int t = 0; t < 8; ++t) aB[t] = *(const u32x4*)(((t & 1) ? hlo : hhi) + 128 + 32 * (t >> 1));
#pragma unroll
    for (int q = 0; q < 5; ++q) *(LAS u32x4*)(lds + RT_WR + doff[q]) = wst[q];
#define RT_CHUNK(A_, kc_) { const int kc = (kc_); \
        asm volatile("s_waitcnt lgkmcnt(0)\n\ts_barrier" ::: "memory"); \
        const LAS unsigned char* WB = lds + RT_WR + (kc & 1) * RT_WBUF; \
        if (kc < 7) { _Pragma("unroll") for (int q = 0; q < 5; ++q) wst[q] = *(const u32x4*)(wsrc + soff[q] + (kc + 1) * 256); } \
        _Pragma("unroll") for (int s = 0; s < 4; ++s) { const u32x4 hw = A_[2 * s], lw = A_[2 * s + 1]; float hf[8], lf[8]; unpack8(hw, hf); unpack8(lw, lf); \
            if (kc + 2 < 8) { A_[2 * s] = *(const u32x4*)(hhi + (kc + 2) * 128 + 32 * s); A_[2 * s + 1] = *(const u32x4*)(hlo + (kc + 2) * 128 + 32 * s); } \
            const f32x4 x0 = {hf[0] + lf[0], hf[1] + lf[1], hf[2] + lf[2], hf[3] + lf[3]}, x1 = {hf[4] + lf[4], hf[5] + lf[5], hf[6] + lf[6], hf[7] + lf[7]}; \
            ssq += (x0[0] * x0[0] + x0[1] * x0[1]) + (x0[2] * x0[2] + x0[3] * x0[3]) + (x1[0] * x1[0] + x1[1] * x1[1]) + (x1[2] * x1[2] + x1[3] * x1[3]); \
            { u32x2 w8; w8.x = pk4_fp8(x0[0], x0[1], x0[2], x0[3]); w8.y = pk4_fp8(x1[0], x1[1], x1[2], x1[3]); *(u32x2*)(xb8 + (size_t)row * 1024 + kc * 128 + 32 * s + 8 * kq) = w8; } \
            const bf16x8 ah = __builtin_bit_cast(bf16x8, hw), al = __builtin_bit_cast(bf16x8, lw); \
            _Pragma("unroll") for (int cb = 0; cb < 5; ++cb) { const bf16x8 bh = *(const LAS bf16x8*)(WB + (16 * cb + i) * 272 + (32 * s + 8 * kq) * 2), bl = *(const LAS bf16x8*)(WB + (80 + 16 * cb + i) * 272 + (32 * s + 8 * kq) * 2); \
                acc[cb] = MFMA16(ah, bh, acc[cb]); acc[cb] = MFMA16(ah, bl, acc[cb]); acc[cb] = MFMA16(al, bh, acc[cb]); } } \
        if (kc < 7) { _Pragma("unroll") for (int q = 0; q < 5; ++q) *(LAS u32x4*)(lds + RT_WR + ((kc + 1) & 1) * RT_WBUF + doff[q]) = wst[q]; } }
#pragma nounroll
    for (int k2 = 0; k2 < 8; k2 += 2) { RT_CHUNK(aA, k2) RT_CHUNK(aB, k2 + 1) }
#undef RT_CHUNK
    ssq += __shfl_xor(ssq, 16); ssq += __shfl_xor(ssq, 32);
    if (kq == 0) RS[wave * 16 + i] = rsqrtf(ssq * (1.f / 1024.f) + EPS);
#pragma unroll
    for (int cb = 0; cb < 5; ++cb)
#pragma unroll
        for (int reg = 0; reg < 4; ++reg) LG[(wave * 16 + 4 * kq + reg) * 80 + 16 * cb + i] = acc[cb][reg];
    __syncthreads();
    if (tid < 128) {
        const int t = rg * 128 + tid; const float rs = RS[tid]; const LAS float* lg = LG + tid * 80;
        float gl[8]; int gs = 0; float gm = -3.4e38f;
#pragma unroll
        for (int j = 0; j < 8; ++j) { gl[j] = rs * lg[j] + BI[j]; if (gl[j] > gm) { gm = gl[j]; gs = j; } }
        float den = 0.f;
#pragma unroll
        for (int j = 0; j < 8; ++j) den += __expf(gl[j] - gm);
        const float gw = 1.f / den;
        float v1 = -3.4e38f, v2 = -3.4e38f; int i1 = 0, i2 = 0;
#pragma unroll
        for (int e = 0; e < 8; ++e) { const float v = rs * lg[16 + 8 * gs + e] + BI[8 + 8 * gs + e];
            if (v > v1) { v2 = v1; i2 = i1; v1 = v; i1 = e; } else if (v > v2) { v2 = v; i2 = e; } }
        const float p1 = 1.f / (1.f + __expf(v2 - v1));
        int* re = (int*)(P.ws + WS_ROUTE + RT_E); float* rgt = (float*)(P.ws + WS_ROUTE + RT_G); float* rr = (float*)(P.ws + WS_ROUTE + RT_RSTD);
        re[2 * t] = 8 * gs + i1; re[2 * t + 1] = 8 * gs + i2; rgt[2 * t] = p1 * gw; rgt[2 * t + 1] = (1.f - p1) * gw; rr[t] = rs;
        atomicAdd((int*)(lds + RT_HS) + 8 * gs + i1, 1); atomicAdd((int*)(lds + RT_HS) + 8 * gs + i2, 1);
    }
    __syncthreads();
    if (tid < 64) ((int*)(P.ws + WS_ROUTE + RT_HIST))[rg * 64 + tid] = HS[tid];
    __syncthreads();
}

DI void lists_phase(const Params& P, LAS unsigned char* lds, int rgA, int rgB) {
    int tid_o = threadIdx.x; asm volatile("" : "+v"(tid_o)); const int tid = tid_o;
    LAS int* TOT = (LAS int*)lds; LAS int* PREA = TOT + 64; LAS int* PREB = TOT + 128; LAS int* PST = TOT + 192; LAS int* EA = TOT + 320; LAS int* PART = TOT + 1024;
    const int* hist = (const int*)(P.ws + WS_ROUTE + RT_HIST);
    const int* re = (const int*)(P.ws + WS_ROUTE + RT_E); const float* rgt = (const float*)(P.ws + WS_ROUTE + RT_G); const float* rr = (const float*)(P.ws + WS_ROUTE + RT_RSTD);
    int* stok = (int*)(P.ws + WS_ROUTE + RT_STOK); int* stk = (int*)(P.ws + WS_ROUTE + RT_STK); float* sg = (float*)(P.ws + WS_ROUTE + RT_SGATE); float* srs = (float*)(P.ws + WS_ROUTE + RT_SRSTD);
    int* texp = (int*)(P.ws + WS_ROUTE + RT_TEXP);
    { const int e = tid & 63, part = tid >> 6; int tot = 0, pa = 0, pb = 0;
#pragma unroll 8
        for (int q = 0; q < 64; ++q) { const int r = part * 64 + q; const int v = hist[r * 64 + e]; tot += v; pa += (r < rgA) ? v : 0; pb += (r < rgB) ? v : 0; }
        PART[part * 64 + e] = tot; PART[512 + part * 64 + e] = pa; PART[1024 + part * 64 + e] = pb; }
    __syncthreads();
    if (tid < 64) { int tot = 0, pa = 0, pb = 0;
#pragma unroll
        for (int p = 0; p < 8; ++p) { tot += PART[p * 64 + tid]; pa += PART[512 + p * 64 + tid]; pb += PART[1024 + p * 64 + tid]; }
        TOT[tid] = tot; PREA[tid] = pa; PREB[tid] = pb; }
    __syncthreads();
    if (tid == 0) { int s = 0; for (int e = 0; e < 64; ++e) { PST[e] = s; s += (TOT[e] + 255) & ~255; } PST[64] = s; }
    __syncthreads();
    for (int pass = 0; pass < 2; ++pass) {
        const int rg = pass ? rgB : rgA; const LAS int* PRE = pass ? PREB : PREA;
        if (rg >= 0) {
            if (tid < 256) EA[tid] = re[rg * 256 + tid];
            __syncthreads();
            if (tid < 256) { const int e = EA[tid]; int rank = 0; for (int a = 0; a < tid; ++a) rank += (EA[a] == e) ? 1 : 0;
                const int slot = PST[e] + PRE[e] + rank, t = rg * 128 + (tid >> 1), k = tid & 1;
                stok[slot] = t; stk[slot] = t | (k << 16); sg[slot] = rgt[rg * 256 + tid]; srs[slot] = rr[t]; ((int*)(P.ws + WS_ROUTE + RT_TSLOT))[2 * t + k] = slot; }
            __syncthreads();
        }
    }
    if (blockIdx.x < 64) { const int e = blockIdx.x; for (int s = PST[e] + TOT[e] + tid; s < PST[e + 1]; s += NTHREADS) { stok[s] = 0; stk[s] = -1; sg[s] = 0.f; srs[s] = 0.f; } }
    if (blockIdx.x == 64) { for (int t = tid; t < MAXTILES; t += NTHREADS) { int e = -1; for (int q = 0; q < 64; ++q) if (PST[q] <= 256 * t && 256 * t < PST[q + 1]) e = q; texp[t] = e; }
        if (tid == 0) texp[MAXTILES] = PST[64] >> 8; }
    __syncthreads();
}

DI void phase_final(const Params& P, bool with_moe) {
    int tid_o = threadIdx.x; asm volatile("" : "+v"(tid_o)); const int tid = tid_o, lane = tid & 63, wave = __builtin_amdgcn_readfirstlane(tid >> 6); const int gw = blockIdx.x * 8 + wave, NGW = gridDim.x * 8;
    const unsigned char* Y = P.ws + WS_Y; const float* g = P.in[22]; const int* tslot = (const int*)(P.ws + WS_ROUTE + RT_TSLOT);
    const bf16* hbase = (const bf16*)(P.ws + WS_PGLA);
    f32x4 gv[4];
#pragma unroll
    for (int j = 0; j < 4; ++j) gv[j] = ((const f32x4*)g)[lane + 64 * j];
    u32x2 hn[4]; int yan[4], ybn[4]; int s0n = 0, s1n = 0;
    int t = gw;
    if (t < TR) { const int s0 = with_moe ? tslot[2 * t] : 0, s1 = with_moe ? tslot[2 * t + 1] : 0;
        const u32x2* hh = (const u32x2*)H1HI(hbase, t) + lane; const int* ya = (const int*)(Y + (size_t)s0 * 1024) + lane; const int* yb = (const int*)(Y + (size_t)s1 * 1024) + lane;
#pragma unroll
        for (int j = 0; j < 4; ++j) { hn[j] = hh[64 * j]; yan[j] = ya[64 * j]; ybn[j] = yb[64 * j]; }
        if (t + NGW < TR && with_moe) { s0n = tslot[2 * (t + NGW)]; s1n = tslot[2 * (t + NGW) + 1]; } }
#pragma nounroll
    for (; t < TR; t += NGW) {
        u32x2 hc[4]; int yac[4], ybc[4];
#pragma unroll
        for (int j = 0; j < 4; ++j) { hc[j] = hn[j]; yac[j] = yan[j]; ybc[j] = ybn[j]; }
        const int tn = t + NGW;
        if (tn < TR) { const u32x2* hh = (const u32x2*)H1HI(hbase, tn) + lane; const int* ya = (const int*)(Y + (size_t)s0n * 1024) + lane; const int* yb = (const int*)(Y + (size_t)s1n * 1024) + lane;
#pragma unroll
            for (int j = 0; j < 4; ++j) { hn[j] = hh[64 * j]; yan[j] = ya[64 * j]; ybn[j] = yb[64 * j]; }
            if (tn + NGW < TR && with_moe) { s0n = tslot[2 * (tn + NGW)]; s1n = tslot[2 * (tn + NGW) + 1]; } }
        f32x4 v[4]; float s = 0.f;
#pragma unroll
        for (int j = 0; j < 4; ++j) { v[j] = (f32x4){bflo(hc[j].x), bfhi(hc[j].x), bflo(hc[j].y), bfhi(hc[j].y)};
            if (with_moe) { const int y0 = yac[j], y1 = ybc[j];
                v[j][0] += (__builtin_amdgcn_cvt_f32_fp8(y0, 0) + __builtin_amdgcn_cvt_f32_fp8(y1, 0)) * 0.125f; v[j][1] += (__builtin_amdgcn_cvt_f32_fp8(y0, 1) + __builtin_amdgcn_cvt_f32_fp8(y1, 1)) * 0.125f;
                v[j][2] += (__builtin_amdgcn_cvt_f32_fp8(y0, 2) + __builtin_amdgcn_cvt_f32_fp8(y1, 2)) * 0.125f; v[j][3] += (__builtin_amdgcn_cvt_f32_fp8(y0, 3) + __builtin_amdgcn_cvt_f32_fp8(y1, 3)) * 0.125f; }
            s += (v[j][0] * v[j][0] + v[j][1] * v[j][1]) + (v[j][2] * v[j][2] + v[j][3] * v[j][3]); }
        const float rs = rsqrtf(wave_sum(s) * (1.f / 1024.f) + EPS);
        f32x4* hr = (f32x4*)(P.out + (size_t)t * 1024) + lane;
#pragma unroll
        for (int j = 0; j < 4; ++j) hr[64 * j] = v[j] * rs * gv[j];
    }
}


#define XB_TMO      128
#define XB_XCNT(j)  (256  + 64 * (j))
#define XB_XSUB(j)  (1280 + 64 * (j))
#define XB_XGEN(j)  (2304 + 64 * (j))
#define XB_TOP      3328
#define XB_TOPGEN   3392
#define XCD_BAR_WORDS 3456
#define XB_SPIN_CAP (1u << 22)
DI unsigned xb_ld(unsigned* p)              { return __hip_atomic_load(p, __ATOMIC_RELAXED, __HIP_MEMORY_SCOPE_AGENT); }
DI unsigned xb_add(unsigned* p, unsigned v) { return __hip_atomic_fetch_add(p, v, __ATOMIC_RELAXED, __HIP_MEMORY_SCOPE_AGENT); }
DI unsigned xb_xcc_id() { return (unsigned)__builtin_amdgcn_s_getreg((3 << 11) | 20) & 0xFu; }
#define XB_SPIN(cond, bar) do { unsigned _sp = 0; while (cond) { __builtin_amdgcn_s_sleep(1); \
    if ((++_sp & 255u) == 0u) { if (xb_ld(&(bar)[XB_TMO])) break; if (_sp > XB_SPIN_CAP) { atomicAdd(&(bar)[XB_TMO], 1u); break; } } } } while (0)
struct XcdBarrier { unsigned* bar; unsigned x; volatile LAS unsigned* st; };
DI XcdBarrier xcd_barrier_post(unsigned* bar, volatile LAS unsigned* st) {
    XcdBarrier b; b.bar = bar; b.x = xb_xcc_id(); b.st = st;
    if (threadIdx.x == 0) (void)xb_add(&bar[XB_XCNT(b.x)], 1u);
    return b;
}
DI void xcd_barrier_complete(unsigned* bar, unsigned x, unsigned& nloc, unsigned& nx) {
    const unsigned G = gridDim.x * gridDim.y * gridDim.z;
    unsigned sum, cnt, mine, sp = 0u;
    for (;;) {
        sum = 0u; cnt = 0u; mine = 0u;
#pragma unroll
        for (unsigned j = 0; j < 16; ++j) { const unsigned c = xb_ld(&bar[XB_XCNT(j)]); sum += c; cnt += (c > 0u) ? 1u : 0u; mine = (j == x) ? c : mine; }
        if (sum == G) break;
        __builtin_amdgcn_s_sleep(1);
        if ((++sp & 255u) == 0u) { if (xb_ld(&bar[XB_TMO])) break; if (sp > XB_SPIN_CAP) { atomicAdd(&bar[XB_TMO], 1u); break; } }
    }
    nloc = mine > 0u ? mine : 1u; nx = cnt > 0u ? cnt : 1u;
}
DI void xcd_barrier(const XcdBarrier& b) {
    asm volatile("s_waitcnt vmcnt(0)" ::: "memory");
    __syncthreads();
    if (threadIdx.x == 0) {
        unsigned* bar = b.bar;
        __builtin_amdgcn_s_waitcnt(0);
        unsigned nloc = b.st[0], nx = b.st[1];
        if (nloc == 0u) { xcd_barrier_complete(bar, b.x, nloc, nx); b.st[0] = nloc; b.st[1] = nx; }
        const unsigned old = xb_add(&bar[XB_XSUB(b.x)], 1u);
        const unsigned gen = old / nloc;
        if (old + 1u == (gen + 1u) * nloc) {
            __builtin_amdgcn_fence(__ATOMIC_RELEASE, "agent");
            asm volatile("s_waitcnt vmcnt(0)" ::: "memory");
            const unsigned og = xb_add(&bar[XB_TOP], 1u);
            const unsigned tg = og / nx;
            if (og + 1u == (tg + 1u) * nx) xb_add(&bar[XB_TOPGEN], 1u);
            else XB_SPIN(xb_ld(&bar[XB_TOPGEN]) == tg, bar);
            __builtin_amdgcn_fence(__ATOMIC_ACQUIRE, "agent");
            xb_add(&bar[XB_XGEN(b.x)], 1u);
            asm volatile("s_waitcnt vmcnt(0)" ::: "memory");
        } else {
            XB_SPIN(xb_ld(&bar[XB_XGEN(b.x)]) == gen, bar);
            __builtin_amdgcn_fence(__ATOMIC_ACQUIRE, "agent");
            asm volatile("s_waitcnt vmcnt(0)" ::: "memory");
        }
    }
    __syncthreads();
}

#ifndef MOE_ENABLED
#define MOE_ENABLED 1
#endif
constexpr int NPH = 13;
__global__ void __launch_bounds__(NTHREADS, 2) mega(Params P) {
    extern __shared__ __attribute__((aligned(16))) unsigned char lds_raw[];
    LAS unsigned char* lds = (LAS unsigned char*)lds_raw;
    cg::grid_group grid = cg::this_grid();
    volatile LAS unsigned* MISC = (volatile LAS unsigned*)(lds + LDS_BYTES - 64);
    if (threadIdx.x < 16) MISC[threadIdx.x] = 0u;
    __syncthreads();
    const XcdBarrier xbar = xcd_barrier_post((unsigned*)(P.ws + WS_CTL + 65536), MISC);
    const int G = gridDim.x, c = blockIdx.x;
#define KWS (P.ws)
#define KXN ((bf16*)P.out)
#define KPDN ((bf16*)(P.ws + WS_PDN))
#define KPGLA ((bf16*)(P.ws + WS_PGLA))
#define RUN_0 { phase_p0(P, lds); }
#define RUN_1 { MapPlain mp{(const char*)KXN, (const char*)(KWS + WS_W1T), (size_t)256 * 1024 * 2, (size_t)256 * 1024 * 2}; DenseOrder<MapPlain> S; S.init(TP / 256, N1 / 256, G, c, mp); \
        EpiProj E{KPDN, KPGLA, (bf16*)(KWS + WS_HALO), (float*)(KWS + WS_SMALL)}; \
        pg8::gemm_phase<EpiProj, DenseOrder<MapPlain>, false>(lds, 1024, 1024, S, E); }
#define RUN_2 { __syncthreads(); prep_dn_phase(P, lds); __syncthreads(); prep_gla_phase(P, lds); }
#define RUN_3 { __syncthreads(); for (int it = c; it < BATCH * 8; it += G) scan_dn_item(P, lds, it); for (int it = c; it < BATCH * 8; it += G) scan_gla_item(P, lds, it); }
#define RUN_4 { __syncthreads(); \
        phase_px(P, lds, G == 256); __syncthreads(); \
        MapReal mp{(const char*)KXN, (const char*)(KWS + WS_WZR), (size_t)2048, (size_t)256 * 1024 * 2}; SplitOrder<MapReal> S; S.init(256, 8, G, c, mp, 6, 4); \
        EpiZR E{KPDN, KPGLA, (const float*)(KWS + WS_SSQ_DN), (const float*)(KWS + WS_SSQ_GLA), P.in[7], P.in[11], KWS + WS_OG8}; \
        pg8::gemm_phase<EpiZR, SplitOrder<MapReal>, false>(lds, 1024, 1024, S, E); }
#define RUN_5 { \
        { MapReal mp{(const char*)KPDN, (const char*)(KWS + WS_WPDN), (size_t)3072 * 2, (size_t)256 * 1024 * 2}; DenseOrder<MapReal> S; S.init(256, 4, G, c, mp); \
            EpiStoreReal E{KPDN + 1024, 3072, 1.f}; pg8::gemm_phase<EpiStoreReal, DenseOrder<MapReal>, false>(lds, 1024, 3072, S, E); } \
        { MapPlain mp{(const char*)(KWS + WS_OG8), (const char*)(KWS + WS_WPGLA), (size_t)256 * 1024, (size_t)256 * 1024}; DenseOrder<MapPlain> S; S.init(256, 4, G, c, mp); \
            EpiStoreReal E{KPDN + 2048, 3072, 1.f / 32.f}; pg8::gemm_phase<EpiStoreReal, DenseOrder<MapPlain>, false, true>(lds, 512, 512, S, E); } }
#define RUN_6 { MapReal mp{(const char*)P.out + XN8_OFF, (const char*)(KWS + WS_WG), (size_t)1024, (size_t)256 * 1024}; DenseOrder<MapReal> S; S.init(256, 8, G, c, mp); \
        EpiMerge E{KPDN + 1024, KPDN + 2048, KPGLA}; pg8::gemm_phase<EpiMerge, DenseOrder<MapReal>, false, true>(lds, 512, 512, S, E); }
#define RUN_7 { MapReal mp{(const char*)KPGLA, (const char*)(KWS + WS_WOUT), (size_t)2048 * 2, (size_t)256 * 1024 * 2}; DenseOrder<MapReal> S; S.init(256, 4, G, c, mp); \
        EpiOut E{P.in[0], (bf16*)P.out, (bf16*)(P.ws + WS_PGLA)}; pg8::gemm_phase<EpiOut, DenseOrder<MapReal>, false>(lds, 1024, 2048, S, E); }
#define RUN_8 { __syncthreads(); for (int rg = c; rg < 512; rg += G) router_group(P, lds, rg); }
#define RUN_9 { __syncthreads(); lists_phase(P, lds, c < 512 ? c : -1, c + G < 512 ? c + G : -1); }
#define RUN_10 { __syncthreads(); const int* texp = (const int*)(KWS + WS_ROUTE + RT_TEXP); \
        ExpertOrder S{texp[MAXTILES], G, c, texp, (const int*)(KWS + WS_ROUTE + RT_STOK), (const char*)(KWS + WS_XB), (const char*)(KWS + WS_WEXP13), (size_t)0, (size_t)1024 * 1024, (size_t)256 * 1024}; \
        EpiE1 E{(const float*)(KWS + WS_ROUTE + RT_SRSTD), KWS + WS_H}; pg8::gemm_phase<EpiE1, ExpertOrder, true, true>(lds, 512, 512, S, E); }
#define RUN_11 { const int* texp = (const int*)(KWS + WS_ROUTE + RT_TEXP); \
        ExpertOrder S{texp[MAXTILES], G, c, texp, (const int*)(KWS + WS_ROUTE + RT_STOK), (const char*)(KWS + WS_H), (const char*)(KWS + WS_WEXP2), (size_t)256 * 512, (size_t)1024 * 512, (size_t)256 * 512}; \
        EpiE2 E{(const float*)(KWS + WS_ROUTE + RT_SGATE), KWS + WS_Y}; pg8::gemm_phase<EpiE2, ExpertOrder, false, true>(lds, 256, 256, S, E); }
#define RUN_12 { phase_final(P, MOE_ENABLED != 0); }
#define SY xcd_barrier(xbar);
#define SY0 grid.sync();
#ifndef PROGRAM
#define PROGRAM RUN_0 SY0 RUN_1 SY RUN_2 SY RUN_3 SY RUN_4 SY RUN_5 SY RUN_6 SY RUN_7 SY RUN_8 SY RUN_9 SY RUN_10 SY RUN_11 SY RUN_12
#endif
    PROGRAM
}

extern "C" void kernel_launch(void* const* d_in, const int* in_sizes, int n_in, void* d_out, int out_size, void* d_ws, size_t ws_size, hipStream_t stream) {
    static int grid = 0;
    if (grid == 0) {
        if (n_in != 23 || out_size != TR * 1024 || ws_size < WS_END) { fprintf(stderr, "kernel_launch: unexpected problem (n_in %d out %d ws %zu)\n", n_in, out_size, ws_size); grid = -1; return; }
        if (hipFuncSetAttribute((const void*)mega, hipFuncAttributeMaxDynamicSharedMemorySize, LDS_BYTES) != hipSuccess) { fprintf(stderr, "kernel_launch: hipFuncSetAttribute failed\n"); grid = -1; return; }
        int dev = 0, cus = 0, per_cu = 0; (void)hipGetDevice(&dev); (void)hipDeviceGetAttribute(&cus, hipDeviceAttributeMultiprocessorCount, dev);
        (void)hipOccupancyMaxActiveBlocksPerMultiprocessor(&per_cu, (const void*)mega, NTHREADS, LDS_BYTES);
        (void)hipGetLastError();
        if (per_cu < 1) { fprintf(stderr, "kernel_launch: occupancy query says %d blocks/CU\n", per_cu); }
        grid = cus;
        if (grid != 256) fprintf(stderr, "kernel_launch: note: %d CUs\n", grid);
    }
    if (grid < 0) return;
    Params p; memset(&p, 0, sizeof(p));
    for (int i = 0; i < 23; ++i) p.in[i] = (const float*)d_in[i];
    p.out = (float*)d_out; p.ws = (unsigned char*)d_ws;
    if (hipMemsetAsync((char*)d_ws + WS_CTL, 0, 1 << 20, stream) != hipSuccess) { fprintf(stderr, "memset failed\n"); return; }
    void* args[] = {&p};
    hipError_t e = hipLaunchCooperativeKernel((const void*)mega, dim3(grid), dim3(NTHREADS), args, LDS_BYTES, stream);
    if (e != hipSuccess) fprintf(stderr, "cooperative launch failed: %s\n", hipGetErrorString(e));
}
```

```cpp
#include <hip/hip_runtime.h>
#include <hip/hip_cooperative_groups.h>
#include <cstdio>
#include <cstdint>
#include <cstring>
namespace cg = cooperative_groups;

#define DI __device__ __forceinline__
#define LAS __attribute__((address_space(3)))
typedef unsigned short bf16;
typedef short bf16x8 __attribute__((ext_vector_type(8)));
typedef float f32x4 __attribute__((ext_vector_type(4)));
typedef float f32x16 __attribute__((ext_vector_type(16)));
typedef unsigned u32x4 __attribute__((ext_vector_type(4)));
typedef unsigned u32x2 __attribute__((ext_vector_type(2)));
typedef __bf16 bf16x2_t __attribute__((ext_vector_type(2)));
typedef float f32x2_t __attribute__((ext_vector_type(2)));

constexpr int DM = 1024, BATCH = 32, SEQ = 2048, NMETA = 16, LP = 2112, NCH = 33;
constexpr int TP = BATCH * LP;
constexpr int TR = BATCH * SEQ;
constexpr int N1 = 5376;
constexpr int NGCH = BATCH * NCH;
constexpr int NIT_DN = NGCH * 8, NIT_GLA = NGCH * 4;
constexpr int MAXTILES = 576, MAXSLOTS = MAXTILES * 256;
constexpr float EPS = 1e-6f;
constexpr int NTHREADS = 512;
constexpr int LDS_BYTES = 163840;

constexpr size_t MiB = 1u << 20;
constexpr size_t XN8_OFF = 144 * MiB;
#define H1HI(base_, t_) ((base_) + ((size_t)((t_) >> 11) * LP + 64 + ((t_) & 2047)) * 2048 + 1024)
constexpr size_t WS_CTL = 0;
#define WS_OG8 (WS_EXT + 64 * MiB)
constexpr size_t WS_W1T = 1 * MiB;
constexpr size_t WS_WZR = 12 * MiB;
constexpr size_t WS_WG = 16 * MiB;
constexpr size_t WS_WPDN = 20 * MiB, WS_WPGLA = 22 * MiB, WS_WOUT = 24 * MiB;
constexpr size_t WS_WRT = 26 * MiB;
constexpr size_t WS_SMALL = 27 * MiB;
constexpr size_t WS_HALO = 36 * MiB;
constexpr size_t WS_SSQ_DN = 55 * MiB;
constexpr size_t WS_SSQ_GLA = 58 * MiB;
constexpr size_t WS_SC_DN = 61 * MiB;
constexpr size_t WS_EBL = 64 * MiB;
constexpr size_t WS_ROUTE = 67 * MiB;
constexpr size_t WS_PDN = 72 * MiB;
constexpr size_t WS_PGLA = 468 * MiB;
constexpr size_t WS_EXT = 732 * MiB;
constexpr size_t WS_ATT = 930 * MiB;
constexpr size_t WS_END = 963 * MiB;
constexpr size_t WS_WEXP13 = WS_EXT;
constexpr size_t WS_WEXP2 = WS_EXT + 128 * MiB;
constexpr size_t WS_XB = WS_PDN;
constexpr size_t WS_H = WS_PDN + 128 * MiB;
constexpr size_t WS_Y = WS_PDN + 252 * MiB;
static_assert(WS_Y + (size_t)MAXSLOTS * 1024 <= WS_PGLA && WS_H + (size_t)MAXSLOTS * 512 <= WS_Y, "MoE overlays");
constexpr size_t RT_E = 0;
constexpr size_t RT_G = 512 * 1024;
constexpr size_t RT_RSTD = 1024 * 1024;
constexpr size_t RT_HIST = 1280 * 1024;
constexpr size_t RT_STOK = 1536 * 1024;
constexpr size_t RT_STK = 2176 * 1024;
constexpr size_t RT_SGATE = 2816 * 1024;
constexpr size_t RT_SRSTD = 3456 * 1024;
constexpr size_t RT_TEXP = 4096 * 1024;
constexpr size_t RT_TSLOT = 4200 * 1024;
static_assert(RT_TSLOT + (size_t)TR * 8 <= 5 * MiB && RT_TEXP + (MAXTILES + 1) * 4 <= RT_TSLOT, "route map");
static_assert(WS_EXT + (size_t)NIT_DN * 24576 <= WS_ATT && WS_ATT + (size_t)NIT_GLA * 8192 <= WS_END, "ws map");
static_assert(WS_PDN + (size_t)TP * 3072 * 2 <= WS_PGLA && WS_PGLA + (size_t)TP * 2048 * 2 <= WS_EXT, "ws map 2");

DI unsigned pk2(float lo, float hi) { f32x2_t v = {lo, hi}; bf16x2_t b = __builtin_convertvector(v, bf16x2_t); return __builtin_bit_cast(unsigned, b); }
DI float bflo(unsigned u) { return __uint_as_float(u << 16); }
DI float bfhi(unsigned u) { return __uint_as_float(u & 0xffff0000u); }
DI float bf2f(bf16 b) { return __uint_as_float(((unsigned)b) << 16); }
DI bf16 f2bf(float f) { return (bf16)(pk2(f, 0.f) & 0xffffu); }
typedef int v8i_t __attribute__((ext_vector_type(8)));
typedef int v4i_t __attribute__((ext_vector_type(4)));
DI unsigned pk4_fp8(float a, float b, float c, float d) { int w = 0; w = __builtin_amdgcn_cvt_pk_fp8_f32(a, b, w, false); w = __builtin_amdgcn_cvt_pk_fp8_f32(c, d, w, true); return (unsigned)w; }
DI float sigmoidf_(float x) { return __builtin_amdgcn_rcpf(1.f + __expf(-x)); }
DI float siluf_(float x) { return x * __builtin_amdgcn_rcpf(1.f + __expf(-x)); }
DI float softplusf_(float x) { return x > 20.f ? x : log1pf(__expf(x)); }
DI float logsigmoidf_(float x) { return fminf(x, 0.f) - __logf(1.f + __expf(-fabsf(x))); }
DI float wave_sum(float v) {
#pragma unroll
    for (int o = 1; o < 64; o <<= 1) v += __shfl_xor(v, o);
    return v;
}
#define LDS_WAIT() asm volatile("s_waitcnt lgkmcnt(0)" ::: "memory")
DI int rowmap(int pm) { return (pm >> 3) * LP + 64 + (pm & 7) * 256; }
DI int tok2row(int t) { return (t >> 11) * LP + 64 + (t & 2047); }

struct Params { const float* in[23]; float* out; unsigned char* ws; };

namespace pg8 {
constexpr int BM = 256, BK = 64, HALF = 128, HTB = HALF * BK * 2, STAGE_BYTES = 8 * HTB;
DI int lds_byte(int r, int c) { const int st = (r >> 4) * 2 + (c >> 5), rr = r & 15, cc = c & 31, ob = rr * 64 + cc * 2; return st * 1024 + (ob ^ (((ob >> 9) & 1) << 5)); }
DI void stage_rc(int b, int& R, int& C) { const int st = b / 1024, sb = b % 1024, swz = sb ^ (((sb >> 9) & 1) << 5); R = (st >> 1) * 16 + swz / 64; C = (st & 1) * 32 + (swz % 64) / 2; }
DI int perm32(int rho) { const int n = rho >> 4, i = rho & 15; return 8 * (i >> 2) + 4 * n + (i & 3); }
struct Unit { const char* a; const char* b; const int* gidx; int pm, pn, aux; };
typedef f32x4 Acc[2][2][4][2];

template <class Epi, class Sched, bool GATHER, bool FP8 = false>
DI void gemm_phase(LAS unsigned char* lds, const int K, const int lda, const Sched& S, const Epi& E) {
    int tid_ = threadIdx.x; asm volatile("" : "+v"(tid_));
    const int tid = tid_, wid = __builtin_amdgcn_readfirstlane(tid >> 6), lane = tid & 63, wr = wid >> 2, wc = wid & 3, fr = lane & 15, fq = lane >> 4;
    int nt_ = K / BK; asm volatile("" : "+s"(nt_)); const int nt = nt_;
    unsigned vA[2][2], nA[2][2], voffB[2]; int Rs[2], Cs[2];
#pragma unroll
    for (int i = 0; i < 2; ++i) { int R, C; stage_rc(tid * 16 + i * 8192, R, C); Rs[i] = R; Cs[i] = C; const int Rb = (R & ~31) + perm32(R & 31);
        voffB[i] = (unsigned)(Rb * K + C) * 2u;
        vA[0][i] = (unsigned)(R * lda + C) * 2u; vA[1][i] = (unsigned)((R + HALF) * lda + C) * 2u; nA[0][i] = vA[0][i]; nA[1][i] = vA[1][i]; }
    const size_t kstep = (size_t)(BK * 2);
    const size_t hstepB = (size_t)HALF * K * 2;
    const unsigned ldsw = (unsigned)wid * 1024u;
    const int aoff = lds_byte(wr * 64 + fr, fq * 8), boff = lds_byte(wc * 32 + fr, fq * 8);
#define PG8_SA(b, h) (((b) * 2 + (h)) * HTB)
#define PG8_SB(b, h) ((4 + (b) * 2 + (h)) * HTB)
#define PG8_STAGEB(bufoff, gbase) do { _Pragma("unroll") for (int _i = 0; _i < 2; ++_i) \
        __builtin_amdgcn_global_load_lds((const unsigned*)((const char*)(gbase) + voffB[_i]), (LAS unsigned*)(lds + (bufoff) + ldsw + _i * 8192), 16, 0, 0); } while (0)
#define PG8_STAGEA(bufoff, gbase, v0, v1) do { \
        __builtin_amdgcn_global_load_lds((const unsigned*)((const char*)(gbase) + (v0)), (LAS unsigned*)(lds + (bufoff) + ldsw), 16, 0, 0); \
        __builtin_amdgcn_global_load_lds((const unsigned*)((const char*)(gbase) + (v1)), (LAS unsigned*)(lds + (bufoff) + ldsw + 8192), 16, 0, 0); } while (0)
#define PG8_LDA(dst, b, h) do { if constexpr (FP8) { _Pragma("unroll") for (int m = 0; m < 4; ++m) { const v4i_t lo_ = *(const LAS v4i_t*)(lds + PG8_SA(b, h) + aoff + m * 2048), hi_ = *(const LAS v4i_t*)(lds + PG8_SA(b, h) + aoff + m * 2048 + 1024); \
            dst##8[m] = __builtin_shufflevector(lo_, hi_, 0, 1, 2, 3, 4, 5, 6, 7); } } \
        else { _Pragma("unroll") for (int m = 0; m < 4; ++m) _Pragma("unroll") for (int k = 0; k < 2; ++k) dst[m][k] = *(const LAS bf16x8*)(lds + PG8_SA(b, h) + aoff + m * 2048 + k * 1024); } } while (0)
#define PG8_LDB(dst, b, h) do { if constexpr (FP8) { _Pragma("unroll") for (int n = 0; n < 2; ++n) { const v4i_t lo_ = *(const LAS v4i_t*)(lds + PG8_SB(b, h) + boff + n * 2048), hi_ = *(const LAS v4i_t*)(lds + PG8_SB(b, h) + boff + n * 2048 + 1024); \
            dst##8[n] = __builtin_shufflevector(lo_, hi_, 0, 1, 2, 3, 4, 5, 6, 7); } } \
        else { _Pragma("unroll") for (int n = 0; n < 2; ++n) _Pragma("unroll") for (int k = 0; k < 2; ++k) dst[n][k] = *(const LAS bf16x8*)(lds + PG8_SB(b, h) + boff + n * 2048 + k * 1024); } } while (0)
#define PG8_MMA(ai, bj, At, Bt) do { __builtin_amdgcn_s_setprio(1); \
        if constexpr (FP8) {   \
            asm volatile("s_nop 4\n\t" \
                "v_mfma_scale_f32_16x16x128_f8f6f4 %0, %8, %10, %0, %14, %14 op_sel_hi:[0,0,0]\n\t" "v_mfma_scale_f32_16x16x128_f8f6f4 %1, %9, %10, %1, %14, %14 op_sel_hi:[0,0,0]\n\t" \
                "v_mfma_scale_f32_16x16x128_f8f6f4 %2, %8, %11, %2, %14, %14 op_sel_hi:[0,0,0]\n\t" "v_mfma_scale_f32_16x16x128_f8f6f4 %3, %9, %11, %3, %14, %14 op_sel_hi:[0,0,0]\n\t" \
                "v_mfma_scale_f32_16x16x128_f8f6f4 %4, %8, %12, %4, %14, %14 op_sel_hi:[0,0,0]\n\t" "v_mfma_scale_f32_16x16x128_f8f6f4 %5, %9, %12, %5, %14, %14 op_sel_hi:[0,0,0]\n\t" \
                "v_mfma_scale_f32_16x16x128_f8f6f4 %6, %8, %13, %6, %14, %14 op_sel_hi:[0,0,0]\n\t" "v_mfma_scale_f32_16x16x128_f8f6f4 %7, %9, %13, %7, %14, %14 op_sel_hi:[0,0,0]" \
                : "+v"(acc[ai][bj][0][0]), "+v"(acc[ai][bj][0][1]), "+v"(acc[ai][bj][1][0]), "+v"(acc[ai][bj][1][1]), "+v"(acc[ai][bj][2][0]), "+v"(acc[ai][bj][2][1]), "+v"(acc[ai][bj][3][0]), "+v"(acc[ai][bj][3][1]) \
                : "v"(Bt##8[0]), "v"(Bt##8[1]), "v"(At##8[0]), "v"(At##8[1]), "v"(At##8[2]), "v"(At##8[3]), "v"(one_scale)); } \
        else { _Pragma("unroll") for (int m = 0; m < 4; ++m) _Pragma("unroll") for (int n = 0; n < 2; ++n) _Pragma("unroll") for (int k = 0; k < 2; ++k) \
            acc[ai][bj][m][n] = __builtin_amdgcn_mfma_f32_16x16x32_bf16(Bt[n][k], At[m][k], acc[ai][bj][m][n], 0, 0, 0); } \
        __builtin_amdgcn_s_setprio(0); } while (0)
#define PG8_WAIT_V(n) asm volatile("s_waitcnt vmcnt(" #n ")" ::: "memory")
#define PG8_WAIT_L(n) asm volatile("s_waitcnt lgkmcnt(" #n ")" ::: "memory")
#define PG8_BAR __builtin_amdgcn_s_barrier()
#define PG8_SCHED __builtin_amdgcn_sched_barrier(0)
#define PG8_GIDX(dst, u) do { if constexpr (GATHER) { _Pragma("unroll") for (int _h = 0; _h < 2; ++_h) _Pragma("unroll") for (int _i = 0; _i < 2; ++_i) \
        dst[_h][_i] = (unsigned)((u).gidx[Rs[_i] + _h * HALF]) * (unsigned)(lda * 2) + (unsigned)(Cs[_i] * 2); } } while (0)
    Unit cur, nxt; int ui = 0;
    if (!S.next(0, cur)) return;
    Acc acc;
#pragma unroll
    for (int a = 0; a < 2; ++a)
#pragma unroll
        for (int b = 0; b < 2; ++b)
#pragma unroll
            for (int m = 0; m < 4; ++m)
#pragma unroll
                for (int n = 0; n < 2; ++n) acc[a][b][m][n] = (f32x4){0.f, 0.f, 0.f, 0.f};
    int one_scale = 0x7f7f7f7f; asm volatile("" : "+v"(one_scale));
    bf16x8 At[4][2], B0[2][2], B1[2][2];
    v8i_t At8[4], B08[2], B18[2];
    const char* cA = cur.a; const char* cB = cur.b;
    PG8_GIDX(vA, cur);
    PG8_STAGEB(PG8_SB(0, 0), cB); PG8_STAGEB(PG8_SB(0, 1), cB + hstepB); PG8_STAGEA(PG8_SA(0, 0), cA, vA[0][0], vA[0][1]); PG8_STAGEA(PG8_SA(0, 1), cA, vA[1][0], vA[1][1]);
    if (wr == 1) PG8_BAR;
    PG8_WAIT_V(2); PG8_BAR;
    PG8_STAGEB(PG8_SB(1, 0), cB + kstep); PG8_STAGEA(PG8_SA(1, 0), cA + kstep, vA[0][0], vA[0][1]); PG8_STAGEB(PG8_SB(1, 1), cB + hstepB + kstep);
    PG8_WAIT_V(6); PG8_BAR;
    for (;;) {
        const bool has_next = S.next(ui + 1, nxt);
        const char* nAp = has_next ? nxt.a : cA; const char* nBp = has_next ? nxt.b : cB;
        for (int t = 0; t < nt; t += 2) {
            const bool last = (t == nt - 2);
            const char* a1 = cA + (size_t)(t + 1) * kstep;
            const char* a2 = last ? nAp : cA + (size_t)(t + 2) * kstep; const char* b2 = last ? nBp : cB + (size_t)(t + 2) * kstep;
            const char* a3 = a2 + kstep; const char* b3 = b2 + kstep;
            unsigned x00 = vA[0][0], x01 = vA[0][1], x10 = vA[1][0], x11 = vA[1][1];
            if constexpr (GATHER) { if (last && has_next) { PG8_GIDX(nA, nxt); x00 = nA[0][0]; x01 = nA[0][1]; x10 = nA[1][0]; x11 = nA[1][1]; } }
            PG8_LDB(B0, 0, 0); PG8_LDB(B1, 0, 1); PG8_SCHED; PG8_LDA(At, 0, 0); PG8_STAGEA(PG8_SA(1, 1), a1, vA[1][0], vA[1][1]);
            PG8_WAIT_V(8); PG8_WAIT_L(0); PG8_BAR; PG8_MMA(0, 0, At, B0); PG8_MMA(0, 1, At, B1); PG8_BAR; PG8_SCHED;
            PG8_LDA(At, 0, 1); PG8_STAGEB(PG8_SB(0, 0), b2); PG8_STAGEB(PG8_SB(0, 1), b2 + hstepB); PG8_STAGEA(PG8_SA(0, 0), a2, x00, x01);
            PG8_WAIT_V(8); PG8_WAIT_L(0); PG8_BAR; PG8_MMA(1, 0, At, B0); PG8_MMA(1, 1, At, B1); PG8_BAR; PG8_SCHED;
            PG8_LDB(B0, 1, 0); PG8_LDB(B1, 1, 1); PG8_SCHED; PG8_LDA(At, 1, 0); PG8_STAGEA(PG8_SA(0, 1), a2, x10, x11);
            PG8_WAIT_V(8); PG8_WAIT_L(0); PG8_BAR; PG8_MMA(0, 0, At, B0); PG8_MMA(0, 1, At, B1); PG8_BAR; PG8_SCHED;
            PG8_LDA(At, 1, 1); PG8_STAGEB(PG8_SB(1, 0), b3); PG8_STAGEB(PG8_SB(1, 1), b3 + hstepB); PG8_STAGEA(PG8_SA(1, 0), a3, x00, x01);
            PG8_WAIT_V(8); PG8_WAIT_L(0); PG8_BAR; PG8_MMA(1, 0, At, B0); PG8_MMA(1, 1, At, B1); PG8_BAR; PG8_SCHED;
        }
        if (wr == 0) PG8_BAR;
        if constexpr (FP8) asm volatile("s_nop 15\n\ts_nop 15" ::: "memory");
        E(acc, cur, wr, wc, fr, fq);
        if (!has_next) break;
#pragma unroll
        for (int a = 0; a < 2; ++a)
#pragma unroll
            for (int b = 0; b < 2; ++b)
#pragma unroll
                for (int m = 0; m < 4; ++m)
#pragma unroll
                    for (int n = 0; n < 2; ++n) acc[a][b][m][n] = (f32x4){0.f, 0.f, 0.f, 0.f};
        cur = nxt; cA = nAp; cB = nBp; ++ui;
        if constexpr (GATHER) {
#pragma unroll
            for (int h = 0; h < 2; ++h)
#pragma unroll
                for (int i = 0; i < 2; ++i) vA[h][i] = nA[h][i]; }
        if (wr == 1) PG8_BAR;
    }
    PG8_WAIT_V(0);
    PG8_BAR;
#undef PG8_SA
#undef PG8_SB
#undef PG8_STAGEA
#undef PG8_STAGEB
#undef PG8_LDA
#undef PG8_LDB
#undef PG8_MMA
#undef PG8_WAIT_V
#undef PG8_WAIT_L
#undef PG8_BAR
#undef PG8_SCHED
#undef PG8_GIDX
}
}

template <class Map> struct DenseOrder {
    int nM, nN, nwg, G, c; Map map;
    DI void init(int nM_, int nN_, int G_, int c_, const Map& m) { nM = nM_; nN = nN_; nwg = nM * nN; G = G_; c = c_; map = m; }
    DI bool next(int i, pg8::Unit& u) const { return next_L((long)i * G + c, u); }
    DI bool next_L(const long L, pg8::Unit& u) const {
        if (L >= nwg) return false;
        int wgid = (int)L; { const int q = nwg / 8, r = nwg % 8, xcd = wgid % 8, off = wgid / 8; wgid = (xcd < r ? xcd * (q + 1) : r * (q + 1) + (xcd - r) * q) + off; }
        const int nig = 8 * nN, gid = wgid / nig, fm = gid * 8, gsz = (nM - fm) < 8 ? (nM - fm) : 8;
        u.pm = fm + ((wgid % nig) % gsz); u.pn = (wgid % nig) / gsz; u.gidx = nullptr; u.aux = 0;
        map(u); return true;
    }
};
template <class Map> struct SplitOrder {
    DenseOrder<Map> D; int NL, EX, G, c; bool on;
    DI void init(int nM_, int nN_, int G_, int c_, const Map& m, int NL_, int EX_) { NL = NL_; EX = EX_; G = G_; c = c_; on = (G_ == 256) && (NL_ * 256 + EX_ * 128 == nM_ * nN_); D.init(nM_, nN_, G_, on ? 0 : c_, m); }
    DI bool next(int i, pg8::Unit& u) const {
        if (!on) return D.next(i, u);
        const bool light = ((c >> 3) & 1) == 0;
        long L;
        if (i < NL) L = (long)i * 256 + c;
        else { if (light || i >= NL + EX) return false; const int d = (c & 7) | ((c >> 4) << 3); L = (long)NL * 256 + (long)(i - NL) * 128 + d; }
        return D.next_L(L, u);
    }
};
struct MapPlain { const char* A; const char* B; size_t astride, bstride;
    DI void operator()(pg8::Unit& u) const { u.a = A + (size_t)u.pm * astride; u.b = B + (size_t)u.pn * bstride; } };
struct MapReal { const char* A; const char* B; size_t arow, bstride;
    DI void operator()(pg8::Unit& u) const { u.a = A + (size_t)rowmap(u.pm) * arow; u.b = B + (size_t)u.pn * bstride; } };
struct ExpertOrder {
    int ntiles, G, c; const int* texp; const int* stok; const char* A; const char* B; size_t atile, bexp, btile;
    DI bool next(int i, pg8::Unit& u) const {
        const long L = (long)i * G + c; if (L >= (long)ntiles * 4) return false;
        const int tile = (int)(L >> 2), pn = (int)(L & 3);
        int e; { const int off_ = __builtin_amdgcn_readfirstlane(tile << 2); asm volatile("s_load_dword %0, %1, %2\n\ts_waitcnt lgkmcnt(0)" : "=s"(e) : "s"(texp), "s"(off_) : "memory"); }
        u.pm = tile; u.pn = pn; u.aux = e; u.gidx = stok + tile * 256; u.a = A + (size_t)tile * atile; u.b = B + (size_t)e * bexp + (size_t)pn * btile; return true;
    }
};

#define EPI_LOOP_ROWS for (int ai = 0; ai < 2; ++ai) _Pragma("unroll") for (int m = 0; m < 4; ++m)
DI u32x4 pack8(const f32x4& v0, const f32x4& v1) { u32x4 w; w.x = pk2(v0[0], v0[1]); w.y = pk2(v0[2], v0[3]); w.z = pk2(v1[0], v1[1]); w.w = pk2(v1[2], v1[3]); return w; }
DI void unpack8(const u32x4 w, float* f) { f[0] = bflo(w.x); f[1] = bfhi(w.x); f[2] = bflo(w.y); f[3] = bfhi(w.y); f[4] = bflo(w.z); f[5] = bfhi(w.z); f[6] = bflo(w.w); f[7] = bfhi(w.w); }

struct EpiProj {
    bf16* pdn; bf16* pgla; bf16* halo; float* small;
    DI void operator()(const pg8::Acc& acc, const pg8::Unit& u, int wr, int wc, int fr, int fq) const {
        const int row0 = u.pm * 256 + wr * 64 + fr, cl = wc * 32 + 8 * fq;
        if (u.pn < 12) {
#pragma unroll
            EPI_LOOP_ROWS { const int R = row0 + ai * 128 + m * 16;
#pragma unroll
                for (int bj = 0; bj < 2; ++bj) { const int col = u.pn * 256 + bj * 128 + cl; const u32x4 w = pack8(acc[ai][bj][m][0], acc[ai][bj][m][1]);
                    *(u32x4*)(pdn + (size_t)R * 3072 + col) = w;
                    if ((R & 63) >= 61) *(u32x4*)(halo + ((size_t)(R >> 6) * 3 + ((R & 63) - 61)) * 3072 + col) = w; } }
        } else if (u.pn < 20) {
#pragma unroll
            EPI_LOOP_ROWS { const int R = row0 + ai * 128 + m * 16;
#pragma unroll
                for (int bj = 0; bj < 2; ++bj) { const int col = (u.pn - 12) * 256 + bj * 128 + cl;
                    *(u32x4*)(pgla + (size_t)R * 2048 + col) = pack8(acc[ai][bj][m][0], acc[ai][bj][m][1]); } }
        } else if (wc == 0) {
#pragma unroll
            EPI_LOOP_ROWS { const int R = row0 + ai * 128 + m * 16; float* p = small + (size_t)R * 32 + 8 * fq;
                *(f32x4*)p = acc[ai][0][m][0]; *(f32x4*)(p + 4) = acc[ai][0][m][1]; }
        }
    }
};
struct EpiZR {
    bf16* pdn; bf16* pgla; const float* ssq_dn; const float* ssq_gla; const float* nw_dn; const float* nw_gla; unsigned char* og8;
    DI void operator()(const pg8::Acc& acc, const pg8::Unit& u, int wr, int wc, int fr, int fq) const {
        const int R0 = rowmap(u.pm) + wr * 64 + fr, cl = wc * 32 + 8 * fq;
        const bool dn = u.pn < 4; const int hd = u.pn - 4;
        f32x4 nw[2][2];
#pragma unroll
        for (int bj = 0; bj < 2; ++bj) { const float* p = dn ? nw_dn + cl : nw_gla + bj * 128 + cl; nw[bj][0] = *(const f32x4*)p; nw[bj][1] = *(const f32x4*)(p + 4); }
#pragma unroll
        for (int am = 0; am < 4; ++am) { const int ai = am >> 1, mb = (am & 1) * 2;
            u32x4 ov[2][2]; float sa[2][2], sb[2][2];
#pragma unroll
            for (int mm = 0; mm < 2; ++mm) { const int R = R0 + ai * 128 + (mb + mm) * 16;
#pragma unroll
                for (int bj = 0; bj < 2; ++bj) {
                    const bf16* op = dn ? pdn + (size_t)R * 3072 + u.pn * 256 + bj * 128 + cl : pgla + (size_t)R * 2048 + 1024 + hd * 256 + bj * 128 + cl;
                    const float* sp = dn ? ssq_dn + (size_t)R * 8 + u.pn * 2 + bj : ssq_gla + (size_t)R * 8 + hd * 2;
                    ov[mm][bj] = *(const u32x4*)op; sa[mm][bj] = sp[0]; sb[mm][bj] = sp[dn ? 0 : 1]; } }
            __builtin_amdgcn_sched_barrier(0);
#pragma unroll
            for (int mm = 0; mm < 2; ++mm) { const int m = mb + mm; const int R = R0 + ai * 128 + m * 16;
#pragma unroll
                for (int bj = 0; bj < 2; ++bj) {
                    bf16* op = dn ? pdn + (size_t)R * 3072 + u.pn * 256 + bj * 128 + cl : pgla + (size_t)R * 2048 + 1024 + hd * 256 + bj * 128 + cl;
                    const float rs = rsqrtf(dn ? sa[mm][bj] * (1.f / 128.f) + EPS : (sa[mm][bj] + sb[mm][bj]) * (1.f / 256.f) + EPS);
                    float o[8]; unpack8(ov[mm][bj], o); f32x4 r0, r1;
#pragma unroll
                    for (int j = 0; j < 4; ++j) { r0[j] = o[j] * rs * nw[bj][0][j] * siluf_(acc[ai][bj][m][0][j]); r1[j] = o[4 + j] * rs * nw[bj][1][j] * siluf_(acc[ai][bj][m][1][j]); }
                    if (dn) *(u32x4*)op = pack8(r0, r1);
                    else { u32x2 w8; w8.x = pk4_fp8(r0[0], r0[1], r0[2], r0[3]); w8.y = pk4_fp8(r1[0], r1[1], r1[2], r1[3]);
                        *(u32x2*)(og8 + (size_t)(u.pm * 256 + wr * 64 + fr + ai * 128 + m * 16) * 1024 + hd * 256 + bj * 128 + cl) = w8; } } }
        }
    }
};
struct EpiStoreReal {
    bf16* dst; int ld; float scale;
    DI void operator()(const pg8::Acc& acc, const pg8::Unit& u, int wr, int wc, int fr, int fq) const {
        const int R0 = rowmap(u.pm) + wr * 64 + fr, cl = u.pn * 256 + wc * 32 + 8 * fq;
#pragma unroll
        EPI_LOOP_ROWS { const int R = R0 + ai * 128 + m * 16;
#pragma unroll
            for (int bj = 0; bj < 2; ++bj) *(u32x4*)(dst + (size_t)R * ld + cl + bj * 128) = pack8(acc[ai][bj][m][0] * scale, acc[ai][bj][m][1] * scale); }
    }
};
struct EpiMerge {
    const bf16* ydn; const bf16* ygla; bf16* merged;
    DI void operator()(const pg8::Acc& acc, const pg8::Unit& u, int wr, int wc, int fr, int fq) const {
        const int R0 = rowmap(u.pm) + wr * 64 + fr, col = u.pn * 128 + wc * 32 + 8 * fq;
        u32x4 ya[2][4], yb[2][4];
#pragma unroll
        for (int ai = 0; ai < 2; ++ai)
#pragma unroll
            for (int m = 0; m < 4; ++m) { const int R = R0 + ai * 128 + m * 16; ya[ai][m] = *(const u32x4*)(ydn + (size_t)R * 3072 + col); yb[ai][m] = *(const u32x4*)(ygla + (size_t)R * 3072 + col); }
        __builtin_amdgcn_sched_barrier(0);
#pragma unroll
        EPI_LOOP_ROWS { const int R = R0 + ai * 128 + m * 16;
            float a[8], b[8]; unpack8(ya[ai][m], a); unpack8(yb[ai][m], b);
            f32x4 r0, r1;
#pragma unroll
            for (int j = 0; j < 4; ++j) { r0[j] = sigmoidf_(acc[ai][0][m][0][j] * (1.f / 32.f)) * a[j] + sigmoidf_(acc[ai][1][m][0][j] * (1.f / 32.f)) * b[j];
                r1[j] = sigmoidf_(acc[ai][0][m][1][j] * (1.f / 32.f)) * a[4 + j] + sigmoidf_(acc[ai][1][m][1][j] * (1.f / 32.f)) * b[4 + j]; }
            *(u32x4*)(merged + (size_t)R * 2048 + col) = pack8(r0, r1); }
    }
};
struct EpiOut {
    const float* x; bf16* hlo; bf16* hhi;
    DI void operator()(const pg8::Acc& acc, const pg8::Unit& u, int wr, int wc, int fr, int fq) const {
        const int t0 = u.pm * 256 + wr * 64 + fr, cl = u.pn * 256 + wc * 32 + 8 * fq;
#pragma unroll
        for (int ai = 0; ai < 2; ++ai)
#pragma unroll
            for (int mp = 0; mp < 2; ++mp) {
                f32x4 xv[2][2][2];
#pragma unroll
                for (int m2 = 0; m2 < 2; ++m2)
#pragma unroll
                    for (int bj = 0; bj < 2; ++bj) { const size_t o = (size_t)(t0 + ai * 128 + (2 * mp + m2) * 16) * 1024 + cl + bj * 128; xv[m2][bj][0] = *(const f32x4*)(x + o); xv[m2][bj][1] = *(const f32x4*)(x + o + 4); }
                __builtin_amdgcn_sched_barrier(0);
#pragma unroll
                for (int m2 = 0; m2 < 2; ++m2)
#pragma unroll
                    for (int bj = 0; bj < 2; ++bj) { const int m = 2 * mp + m2, t = t0 + ai * 128 + m * 16, cc = cl + bj * 128;
                        const f32x4 v0 = xv[m2][bj][0] + acc[ai][bj][m][0], v1 = xv[m2][bj][1] + acc[ai][bj][m][1];
                        const u32x4 hi = pack8(v0, v1); float hf[8]; unpack8(hi, hf);
                        const f32x4 l0 = {v0[0] - hf[0], v0[1] - hf[1], v0[2] - hf[2], v0[3] - hf[3]}, l1 = {v1[0] - hf[4], v1[1] - hf[5], v1[2] - hf[6], v1[3] - hf[7]};
                        *(u32x4*)(H1HI(hhi, t) + cc) = hi; *(u32x4*)(hlo + (size_t)t * 1024 + cc) = pack8(l0, l1); }
                __builtin_amdgcn_sched_barrier(0);
            }
    }
};
struct EpiE1 {
    const float* srstd; unsigned char* H;
    DI void operator()(const pg8::Acc& acc, const pg8::Unit& u, int wr, int wc, int fr, int fq) const {
        const int s0 = u.pm * 256 + wr * 64 + fr, col = u.pn * 128 + wc * 32 + 8 * fq;
        float rsv[2][4];
#pragma unroll
        for (int ai = 0; ai < 2; ++ai)
#pragma unroll
            for (int m = 0; m < 4; ++m) rsv[ai][m] = srstd[s0 + ai * 128 + m * 16] * (1.f / 32.f);
        __builtin_amdgcn_sched_barrier(0);
#pragma unroll
        EPI_LOOP_ROWS { const int s = s0 + ai * 128 + m * 16; const float rs = rsv[ai][m]; f32x4 r0, r1;
#pragma unroll
            for (int j = 0; j < 4; ++j) { r0[j] = siluf_(rs * acc[ai][0][m][0][j]) * (rs * acc[ai][1][m][0][j]); r1[j] = siluf_(rs * acc[ai][0][m][1][j]) * (rs * acc[ai][1][m][1][j]); }
            u32x2 w; w.x = pk4_fp8(r0[0], r0[1], r0[2], r0[3]); w.y = pk4_fp8(r1[0], r1[1], r1[2], r1[3]);
            *(u32x2*)(H + (size_t)s * 512 + col) = w; }
    }
};
struct EpiE2 {
    const float* sgate; unsigned char* Y;
    DI void operator()(const pg8::Acc& acc, const pg8::Unit& u, int wr, int wc, int fr, int fq) const {
        const int s0 = u.pm * 256 + wr * 64 + fr, cl = u.pn * 256 + wc * 32 + 8 * fq;
        float gv[2][4];
#pragma unroll
        for (int ai = 0; ai < 2; ++ai)
#pragma unroll
            for (int m = 0; m < 4; ++m) gv[ai][m] = sgate[s0 + ai * 128 + m * 16] * (8.f / 16.f);
        __builtin_amdgcn_sched_barrier(0);
#pragma unroll
        EPI_LOOP_ROWS { const int s = s0 + ai * 128 + m * 16; const float g = gv[ai][m]; unsigned char* yp = Y + (size_t)s * 1024 + cl;
#pragma unroll
            for (int bj = 0; bj < 2; ++bj) { const f32x4 a0 = acc[ai][bj][m][0] * g, a1 = acc[ai][bj][m][1] * g; u32x2 w; w.x = pk4_fp8(a0[0], a0[1], a0[2], a0[3]); w.y = pk4_fp8(a1[0], a1[1], a1[2], a1[3]);
                *(u32x2*)(yp + bj * 128) = w; } }
    }
};

DI void transpose_item(const float* __restrict__ W, int ldw, int c0, int c1, int k0, const float* __restrict__ kscale,
                       bf16* __restrict__ WT, size_t drow0, int ldk, LAS float* scr, int lane) {
    const int j = lane & 31, col = (j < 16) ? (c0 + j) : (c1 + j - 16);
#pragma unroll 8
    for (int i = 0; i < 32; ++i) { const int kk = 2 * i + (lane >> 5); float v = W[(size_t)(k0 + kk) * ldw + col]; if (kscale) v *= kscale[k0 + kk]; scr[kk * 33 + j] = v; }
    LDS_WAIT();
    const int c = lane & 7;
#pragma unroll
    for (int jj = 0; jj < 4; ++jj) { const int n = (lane >> 3) + 8 * jj; const LAS float* s = scr + (8 * c) * 33 + n;
        u32x4 o; o.x = pk2(s[0 * 33], s[1 * 33]); o.y = pk2(s[2 * 33], s[3 * 33]); o.z = pk2(s[4 * 33], s[5 * 33]); o.w = pk2(s[6 * 33], s[7 * 33]);
        *(u32x4*)(WT + (drow0 + n) * ldk + k0 + 8 * c) = o; }
    LDS_WAIT();
}

DI void transpose_item8(const float* __restrict__ W, int ldw, int c0, int c1, int k0, const float* __restrict__ kscale, float scale,
                        unsigned char* __restrict__ WT, size_t drow0, int ldk, LAS float* scr, int lane) {
    const int j = lane & 31, col = (j < 16) ? (c0 + j) : (c1 + j - 16);
#pragma unroll 8
    for (int i = 0; i < 32; ++i) { const int kk = 2 * i + (lane >> 5); float v = W[(size_t)(k0 + kk) * ldw + col] * scale; if (kscale) v *= kscale[k0 + kk]; scr[kk * 33 + j] = v; }
    LDS_WAIT();
    const int c = lane & 7;
#pragma unroll
    for (int jj = 0; jj < 4; ++jj) { const int n = (lane >> 3) + 8 * jj; const LAS float* s = scr + (8 * c) * 33 + n;
        u32x2 o; o.x = pk4_fp8(s[0 * 33], s[1 * 33], s[2 * 33], s[3 * 33]); o.y = pk4_fp8(s[4 * 33], s[5 * 33], s[6 * 33], s[7 * 33]);
        *(u32x2*)(WT + (drow0 + n) * ldk + k0 + 8 * c) = o; }
    LDS_WAIT();
}

struct P0Item { const float* src; unsigned char* dst; size_t drow0; int ldw, c0, c1, k0, fp8; };
DI P0Item p0_decode(const Params& P, int r) {
    constexpr int I_W1 = 161 * 16, I_ZR = 64 * 16, I_G = 64 * 16, I_P = 32 * 16;
    P0Item x; x.src = P.in[3]; x.ldw = 9248; x.fp8 = 0;
    if (r < I_W1) { const int nb = r >> 4, kb = r & 15;
        if (nb < 96) { x.c0 = 32 * nb; x.c1 = x.c0 + 16; } else if (nb < 160) { x.c0 = 4112 + 32 * (nb - 96); x.c1 = x.c0 + 16; } else { x.c0 = 4096; x.c1 = 7184; }
        x.k0 = 64 * kb; x.dst = P.ws + WS_W1T; x.drow0 = (size_t)32 * nb; return x; }
    r -= I_W1;
    if (r < I_ZR) { const int nb = r >> 4, kb = r & 15; x.c0 = (nb < 32) ? 3072 + 32 * nb : 6160 + 32 * (nb - 32); x.c1 = x.c0 + 16; x.k0 = 64 * kb; x.dst = P.ws + WS_WZR; x.drow0 = (size_t)32 * nb; return x; }
    r -= I_ZR;
    if (r < I_G) { const int nb = r >> 4, kb = r & 15, pn = nb >> 3, q = nb & 7; x.c0 = (q < 4) ? 7200 + 128 * pn + 32 * q : 8224 + 128 * pn + 32 * (q - 4); x.c1 = x.c0 + 16; x.k0 = 64 * kb;
        x.dst = P.ws + WS_WG; x.drow0 = (size_t)32 * nb; x.fp8 = 1; return x; }
    r -= I_G;
    { const int which = r / I_P, rr = r % I_P, nb = rr >> 4, kb = rr & 15;
        x.src = which == 0 ? P.in[8] : (which == 1 ? P.in[12] : P.in[13]); x.ldw = 1024; x.c0 = 32 * nb; x.c1 = x.c0 + 16; x.k0 = 64 * kb;
        x.dst = P.ws + (which == 0 ? WS_WPDN : (which == 1 ? WS_WPGLA : WS_WOUT)); x.drow0 = (size_t)32 * nb; x.fp8 = (which == 1); }
    return x;
}
DI void p0_load(const P0Item& x, f32x4 (&v)[8], int lane) {
    const int row = lane >> 3, col = (((lane >> 2) & 1) ? x.c1 : x.c0) + 4 * (lane & 3);
#pragma unroll
    for (int i = 0; i < 8; ++i) v[i] = *(const f32x4*)(x.src + (size_t)(x.k0 + 8 * i + row) * x.ldw + col);
}
DI void phase_p0(const Params& P, LAS unsigned char* lds) {
    int tid_o = threadIdx.x; asm volatile("" : "+v"(tid_o)); const int tid = tid_o, lane = tid & 63, wave = __builtin_amdgcn_readfirstlane(tid >> 6);
    const int gw = blockIdx.x * 8 + wave, NGW = gridDim.x * 8;
    LAS float* scr = (LAS float*)(lds + wave * 8448);
    unsigned char* ws = P.ws;
    const float* w_in = P.in[3];
    constexpr int I_W1 = 161 * 16, I_ZR = 64 * 16, I_G = 64 * 16, I_P = 32 * 16;
    constexpr int NITEMS = I_W1 + I_ZR + I_G + 3 * I_P;
    { f32x4 v[8];
        int it = gw;
        if (it < NITEMS) { const P0Item x0 = p0_decode(P, it); p0_load(x0, v, lane); }
#pragma nounroll
        for (; it < NITEMS; it += NGW) {
            { const int row = lane >> 3, j0 = ((lane >> 2) & 1) * 16 + 4 * (lane & 3);
#pragma unroll
                for (int i = 0; i < 8; ++i) { LAS float* d = scr + (8 * i + row) * 33 + j0; d[0] = v[i][0]; d[1] = v[i][1]; d[2] = v[i][2]; d[3] = v[i][3]; } }
            LDS_WAIT();
            if (it + NGW < NITEMS) { const P0Item nxt = p0_decode(P, it + NGW); p0_load(nxt, v, lane); }
            { const P0Item cur = p0_decode(P, it); const int c = lane & 7;
#pragma unroll
                for (int jj = 0; jj < 4; ++jj) { const int n = (lane >> 3) + 8 * jj; const LAS float* s = scr + (8 * c) * 33 + n;
                    if (cur.fp8) { u32x2 o; o.x = pk4_fp8(s[0 * 33] * 32.f, s[1 * 33] * 32.f, s[2 * 33] * 32.f, s[3 * 33] * 32.f); o.y = pk4_fp8(s[4 * 33] * 32.f, s[5 * 33] * 32.f, s[6 * 33] * 32.f, s[7 * 33] * 32.f);
                        *(u32x2*)(cur.dst + (cur.drow0 + n) * 1024 + cur.k0 + 8 * c) = o; }
                    else { u32x4 o; o.x = pk2(s[0 * 33], s[1 * 33]); o.y = pk2(s[2 * 33], s[3 * 33]); o.z = pk2(s[4 * 33], s[5 * 33]); o.w = pk2(s[6 * 33], s[7 * 33]);
                        *(u32x4*)((bf16*)cur.dst + (cur.drow0 + n) * 1024 + cur.k0 + 8 * c) = o; } } }
            LDS_WAIT();
        } }
    { u32x4* z = (u32x4*)(ws + WS_W1T + (size_t)5152 * 1024 * 2); const int n16 = 224 * 1024 * 2 / 16;
        for (int i = blockIdx.x * NTHREADS + tid; i < n16; i += gridDim.x * NTHREADS) z[i] = (u32x4){0u, 0u, 0u, 0u}; }
    { bf16* wh = (bf16*)(ws + WS_WRT); bf16* wl = wh + 80 * 1024; const float* nf = P.in[14]; const float* wg = P.in[15]; const float* wrt = P.in[17];
        for (int i = blockIdx.x * NTHREADS + tid; i < 1024 * 80; i += gridDim.x * NTHREADS) { const int n = i >> 10, k = i & 1023;
            const float v = (n < 8 ? wg[k * 8 + n] : (n < 16 ? 0.f : wrt[k * 64 + (n - 16)])) * nf[k]; const bf16 hi = f2bf(v); wh[i] = hi; wl[i] = f2bf(v - bf2f(hi)); } }
    bf16* xn = (bf16*)P.out; const float* x = P.in[0]; const float* meta = P.in[1]; const float* g = P.in[2]; unsigned char* xn8 = (unsigned char*)P.out + XN8_OFF;
    auto rowsrc = [&](int r) -> const float* { const int b = r / LP, p = r - b * LP; return p < 48 ? nullptr : (p < 64 ? meta + (size_t)(p - 48) * 1024 : x + ((size_t)b * SEQ + (p - 64)) * 1024); };
    f32x4 gv[4];
#pragma unroll
    for (int j = 0; j < 4; ++j) gv[j] = ((const f32x4*)g)[lane + 64 * j];
    f32x4 vn[4], vm[4]; const float* sn = nullptr; const float* sm = nullptr; int r = gw;
    if (r < TP) { sn = rowsrc(r); if (sn) {
#pragma unroll
        for (int j = 0; j < 4; ++j) vn[j] = ((const f32x4*)sn)[lane + 64 * j]; } }
    if (r + NGW < TP) { sm = rowsrc(r + NGW); if (sm) {
#pragma unroll
        for (int j = 0; j < 4; ++j) vm[j] = ((const f32x4*)sm)[lane + 64 * j]; } }
    for (; r < TP; r += NGW) {
        f32x4 v[4]; const float* sc = sn;
#pragma unroll
        for (int j = 0; j < 4; ++j) { v[j] = vn[j]; vn[j] = vm[j]; }
        sn = sm;
        const int rn = r + 2 * NGW; sm = nullptr;
        if (rn < TP) { sm = rowsrc(rn); if (sm) {
#pragma unroll
            for (int j = 0; j < 4; ++j) vm[j] = ((const f32x4*)sm)[lane + 64 * j]; } }
        unsigned long long* o8 = (unsigned long long*)(xn + (size_t)r * 1024) + lane; unsigned* o4 = (unsigned*)(xn8 + (size_t)r * 1024) + lane;
        if (!sc) {
#pragma unroll
            for (int j = 0; j < 4; ++j) { o8[64 * j] = 0ull; o4[64 * j] = 0u; }
            continue; }
        float s = 0.f;
#pragma unroll
        for (int j = 0; j < 4; ++j) s += (v[j][0] * v[j][0] + v[j][1] * v[j][1]) + (v[j][2] * v[j][2] + v[j][3] * v[j][3]);
        const float rs = rsqrtf(wave_sum(s) * (1.f / 1024.f) + EPS);
#pragma unroll
        for (int j = 0; j < 4; ++j) { const f32x4 gg = gv[j];
            o8[64 * j] = (unsigned long long)pk2(v[j][0] * rs * gg[0], v[j][1] * rs * gg[1]) | ((unsigned long long)pk2(v[j][2] * rs * gg[2], v[j][3] * rs * gg[3]) << 32);
            o4[64 * j] = pk4_fp8(v[j][0] * rs * gg[0], v[j][1] * rs * gg[1], v[j][2] * rs * gg[2], v[j][3] * rs * gg[3]); }
    }
}

struct PxItem { const float* src; unsigned char* dst; size_t drow0; int ldw, c0, k0, ldk, hasks; float sc; };
DI PxItem px_decode(const Params& P, int it) {
    constexpr int I13 = 32 * 16, I2 = 32 * 8;
    PxItem x; const int e = it / (I13 + I2); int r = it % (I13 + I2);
    if (r < I13) { const int nb = r >> 4, kb = r & 15, pn = nb >> 3, q = nb & 7; x.src = (q < 4 ? P.in[19] : P.in[20]) + (size_t)e * 1024 * 512; x.ldw = 512; x.c0 = 128 * pn + 32 * (q & 3); x.k0 = 64 * kb;
        x.hasks = 1; x.sc = 32.f; x.dst = P.ws + WS_WEXP13 + (size_t)e * 1024 * 1024; x.drow0 = (size_t)32 * nb; x.ldk = 1024; }
    else { r -= I13; const int nb = r >> 3, kb = r & 7; x.src = P.in[21] + (size_t)e * 512 * 1024; x.ldw = 1024; x.c0 = 32 * nb; x.k0 = 64 * kb;
        x.hasks = 0; x.sc = 16.f; x.dst = P.ws + WS_WEXP2 + (size_t)e * 1024 * 512; x.drow0 = (size_t)32 * nb; x.ldk = 512; }
    return x;
}
DI void px_load(const PxItem& x, const float* nf, f32x4 (&v)[8], float (&ksv)[8], int lane) {
    const int row = lane >> 3, col = x.c0 + ((lane >> 2) & 1) * 16 + 4 * (lane & 3);
#pragma unroll
    for (int i = 0; i < 8; ++i) { v[i] = *(const f32x4*)(x.src + (size_t)(x.k0 + 8 * i + row) * x.ldw + col); ksv[i] = nf[x.k0 + 8 * i + row]; }
}
DI void phase_px(const Params& P, LAS unsigned char* lds, const bool split) {
    int tid_o = threadIdx.x; asm volatile("" : "+v"(tid_o)); const int tid = tid_o, lane = tid & 63, wave = __builtin_amdgcn_readfirstlane(tid >> 6);
    if (split && ((blockIdx.x >> 3) & 1)) return;
    const int gw = split ? (int)(((blockIdx.x & 7) | ((blockIdx.x >> 4) << 3)) * 8 + wave) : (int)(blockIdx.x * 8 + wave), NGW = split ? 1024 : (int)gridDim.x * 8;
    LAS float* scr = (LAS float*)(lds + wave * 8448);
    constexpr int NIT = 64 * (32 * 16 + 32 * 8);
    const float* nf = P.in[14];
    f32x4 va[8], vb[8]; float ka[8], kb[8];
#define PX_PROCESS(v_, k_, it_, nxt_) { \
        { const PxItem cur = px_decode(P, (it_)); const int row = lane >> 3, j0 = ((lane >> 2) & 1) * 16 + 4 * (lane & 3); \
            _Pragma("unroll") for (int i = 0; i < 8; ++i) { LAS float* d = scr + (8 * i + row) * 33 + j0; const float g = cur.hasks ? k_[i] * cur.sc : cur.sc; d[0] = v_[i][0] * g; d[1] = v_[i][1] * g; d[2] = v_[i][2] * g; d[3] = v_[i][3] * g; } } \
        LDS_WAIT(); \
        if ((nxt_) < NIT) { const PxItem nxt = px_decode(P, (nxt_)); px_load(nxt, nf, v_, k_, lane); } \
        { const PxItem cur = px_decode(P, (it_)); const int c = lane & 7; \
            _Pragma("unroll") for (int jj = 0; jj < 4; ++jj) { const int n = (lane >> 3) + 8 * jj; const LAS float* s = scr + (8 * c) * 33 + n; \
                u32x2 o; o.x = pk4_fp8(s[0 * 33], s[1 * 33], s[2 * 33], s[3 * 33]); o.y = pk4_fp8(s[4 * 33], s[5 * 33], s[6 * 33], s[7 * 33]); \
                *(u32x2*)(cur.dst + (cur.drow0 + n) * cur.ldk + cur.k0 + 8 * c) = o; } } \
        LDS_WAIT(); }
    if (gw < NIT) { const PxItem x0 = px_decode(P, gw); px_load(x0, nf, va, ka, lane); }
    if (gw + NGW < NIT) { const PxItem x1 = px_decode(P, gw + NGW); px_load(x1, nf, vb, kb, lane); }
#pragma nounroll
    for (int it = gw; it < NIT; it += 2 * NGW) {
        PX_PROCESS(va, ka, it, it + 2 * NGW)
        if (it + NGW < NIT) PX_PROCESS(vb, kb, it + NGW, it + 3 * NGW)
    }
#undef PX_PROCESS
}

#define MFMA32(a, b, c) __builtin_amdgcn_mfma_f32_32x32x16_bf16((a), (b), (c), 0, 0, 0)
#define MFMA16(a, b, c) __builtin_amdgcn_mfma_f32_16x16x32_bf16((a), (b), (c), 0, 0, 0)
DI bf16x8 lds_rowfrag(const LAS unsigned char* tile, int pitchB, int row, int k0) { return *(const LAS bf16x8*)(tile + row * pitchB + k0 * 2); }
DI bf16x8 lds_colfrag(const LAS unsigned char* tile, int pitchB, int col, int k0) {
    const LAS bf16* p = (const LAS bf16*)(tile + k0 * pitchB) + col; const int ps = pitchB / 2; u32x4 w;
    w.x = (unsigned)p[0] | ((unsigned)p[ps] << 16); w.y = (unsigned)p[2 * ps] | ((unsigned)p[3 * ps] << 16);
    w.z = (unsigned)p[4 * ps] | ((unsigned)p[5 * ps] << 16); w.w = (unsigned)p[6 * ps] | ((unsigned)p[7 * ps] << 16);
    return __builtin_bit_cast(bf16x8, w);
}
constexpr int PD_RAW = 0, PD_AM = 0, PD_QT = 51456, PD_KT = PD_QT + 17408, PD_VT = PD_KT + 17408, PD_SC = PD_VT + 17408, PD_CW = PD_SC + 1536, PD_TD = PD_CW + 6144, PD_UT = PD_TD + 2048, PD_WS = PD_UT + 4 * 4608;
static_assert(PD_WS + 4 * 5120 <= LDS_BYTES - 64, "prep_dn LDS map");
DI bf16x8 packacc(const f32x4& a, const f32x4& b) { u32x4 w; w.x = pk2(a[0], a[1]); w.y = pk2(a[2], a[3]); w.z = pk2(b[0], b[1]); w.w = pk2(b[2], b[3]); return __builtin_bit_cast(bf16x8, w); }
#define MFMAF(a, b, c) __builtin_amdgcn_mfma_f32_16x16x4f32((a), (b), (c), 0, 0, 0)

DI void prep_dn_phase(const Params& P, LAS unsigned char* lds) {
    int tid_o = threadIdx.x; asm volatile("" : "+v"(tid_o)); const int tid = tid_o, lane = tid & 63, wave = __builtin_amdgcn_readfirstlane(tid >> 6);
    const int G = gridDim.x;
    bf16* pdn = (bf16*)(P.ws + WS_PDN); const bf16* halo = (const bf16*)(P.ws + WS_HALO); const float* small = (const float*)(P.ws + WS_SMALL);
    LAS float* SC = (LAS float*)(lds + PD_SC);
    LAS float* AM = (LAS float*)(lds + PD_AM);
    LAS float* CW = (LAS float*)(lds + PD_CW);
    u32x4 pf[7]; f32x4 pfw; float pfa = 0.f, pfb = 0.f;
#define PDN_PREFETCH(it_) do { const int h_ = (it_) & 7, gch_ = (it_) >> 3, c_ = gch_ % NCH, R0_ = gch_ * 64; \
        _Pragma("unroll") for (int q_ = 0; q_ < 7; ++q_) { const int p_ = tid + 512 * q_; pf[q_] = (u32x4){0u, 0u, 0u, 0u}; \
            if (p_ < 3216) { const int row_ = p_ / 48, rem_ = p_ - row_ * 48, seg_ = rem_ >> 4, c16_ = rem_ & 15; \
                if (row_ >= 3) pf[q_] = *(const u32x4*)(pdn + (size_t)(R0_ + row_ - 3) * 3072 + seg_ * 1024 + h_ * 128 + c16_ * 8); \
                else if (c_ > 0) pf[q_] = *(const u32x4*)(halo + ((size_t)(gch_ - 1) * 3 + row_) * 3072 + seg_ * 1024 + h_ * 128 + c16_ * 8); } } \
        if (tid < 384) { const int j_ = tid / 96, r_ = tid - j_ * 96, seg_ = r_ >> 5, c4_ = r_ & 31; pfw = *(const f32x4*)(P.in[4] + j_ * 3072 + seg_ * 1024 + h_ * 128 + c4_ * 4); } \
        if (tid < 64) { pfa = small[(size_t)(R0_ + tid) * 32 + h_]; pfb = small[(size_t)(R0_ + tid) * 32 + 8 + h_]; } } while (0)
    const bool swz = (G == 256);
#define PDN_ITEM(k_) (swz ? ((((k_) * 8 + (blockIdx.x & 7)) * 4 + (blockIdx.x >> 6)) * 8 + ((blockIdx.x >> 3) & 7)) : ((int)blockIdx.x + (k_) * G))
    const int nk = swz ? NIT_DN / 256 : ((int)blockIdx.x < NIT_DN ? (NIT_DN - (int)blockIdx.x + G - 1) / G : 0);
    if (nk > 0) PDN_PREFETCH(PDN_ITEM(0));
#pragma nounroll
    for (int kk = 0; kk < nk; ++kk) { const int item = PDN_ITEM(kk);
        const int h = item & 7, gch = item >> 3, c = gch % NCH; const int R0 = gch * 64;
        unsigned char* ext = P.ws + WS_EXT + (size_t)item * 24576; float* scdn = (float*)(P.ws + WS_SC_DN) + (size_t)item * 80;
#pragma unroll
        for (int q = 0; q < 7; ++q) { const int p = tid + 512 * q; if (p < 3216) { const int row = p / 48, rem = p - row * 48; *(LAS u32x4*)(lds + PD_RAW + row * 768 + rem * 16) = pf[q]; } }
        if (tid < 384) { const int j = tid / 96, r = tid - j * 96; *(LAS f32x4*)(CW + j * 384 + r * 4) = pfw; }
        if (tid < 64) {
            const bool pad = (c == 0 && tid < 48);
            float g = pad ? 0.f : -__expf(P.in[5][h]) * softplusf_(pfa + P.in[6][h]);
            const float beta = pad ? 0.f : sigmoidf_(pfb);
#pragma unroll
            for (int o = 1; o < 64; o <<= 1) { const float t = __shfl_up(g, o); if (lane >= o) g += t; }
            SC[tid] = g; SC[64 + tid] = beta; SC[256 + tid] = __expf(g);
            const float gl = __shfl(g, 63);
            scdn[tid] = __expf(gl - g); if (tid == 0) scdn[64] = __expf(gl);
        }
        __syncthreads();
        if (kk + 1 < nk) PDN_PREFETCH(PDN_ITEM(kk + 1));
#pragma unroll
        for (int rnd = 0; rnd < 3; ++rnd) { const int idx = tid + 512 * rnd; const int rg = idx / 192, cp = idx - rg * 192, tsr = cp >> 6, colp = cp & 63;
            float w0[4], w1[4];
#pragma unroll
            for (int j = 0; j < 4; ++j) { w0[j] = CW[j * 384 + 2 * cp]; w1[j] = CW[j * 384 + 2 * cp + 1]; }
            const LAS unsigned char* rp = lds + PD_RAW + (8 * rg) * 768 + cp * 4;
            float r0[3], r1[3];
#pragma unroll
            for (int j = 0; j < 3; ++j) { const unsigned v = *(const LAS unsigned*)(rp + j * 768); r0[j] = bflo(v); r1[j] = bfhi(v); }
            LAS unsigned char* tile = lds + PD_QT + tsr * 17408;
#pragma unroll
            for (int ii = 0; ii < 8; ++ii) { const unsigned v = *(const LAS unsigned*)(rp + (3 + ii) * 768); const float x0 = bflo(v), x1 = bfhi(v);
                const float o0 = w0[0] * r0[0] + w0[1] * r0[1] + w0[2] * r0[2] + w0[3] * x0, o1 = w1[0] * r1[0] + w1[1] * r1[1] + w1[2] * r1[2] + w1[3] * x1;
                r0[0] = r0[1]; r0[1] = r0[2]; r0[2] = x0; r1[0] = r1[1]; r1[1] = r1[2]; r1[2] = x1;
                *(LAS unsigned*)(tile + (8 * rg + ii) * 272 + 4 * colp) = pk2(siluf_(o0), siluf_(o1)); } }
        __syncthreads();
        { const int i = tid >> 3, part = tid & 7; const LAS unsigned char* qp = lds + PD_QT + i * 272 + part * 32; const LAS unsigned char* kp = lds + PD_KT + i * 272 + part * 32;
            float sq = 0.f, sk = 0.f;
#pragma unroll
            for (int j = 0; j < 2; ++j) { float f[8]; unpack8(*(const LAS u32x4*)(qp + 16 * j), f);
#pragma unroll
                for (int e = 0; e < 8; ++e) sq += f[e] * f[e];
                unpack8(*(const LAS u32x4*)(kp + 16 * j), f);
#pragma unroll
                for (int e = 0; e < 8; ++e) sk += f[e] * f[e]; }
            sq += __shfl_xor(sq, 1); sq += __shfl_xor(sq, 2); sq += __shfl_xor(sq, 4); sk += __shfl_xor(sk, 1); sk += __shfl_xor(sk, 2); sk += __shfl_xor(sk, 4);
            if (part == 0) { SC[128 + i] = rsqrtf(sq + EPS) * 0.08838834764831845f; SC[192 + i] = rsqrtf(sk + EPS); } }
        __syncthreads();
        { const int which = wave >> 2, qd = wave & 3, r = lane & 31, hh = lane >> 5;
            f32x16 acc;
#pragma unroll
            for (int e = 0; e < 16; ++e) acc[e] = 0.f;
            if (which == 0) { const int qi = qd >> 1, qj = qd & 1;
                if (!(qi == 0 && qj == 1)) {
#pragma unroll
                    for (int s = 0; s < 8; ++s) acc = MFMA32(lds_rowfrag(lds + PD_KT, 272, 32 * qi + r, 16 * s + 8 * hh), lds_rowfrag(lds + PD_KT, 272, 32 * qj + r, 16 * s + 8 * hh), acc); }
                const int j = 32 * qj + r; const float gcj = SC[j], rkj = SC[192 + j];
#pragma unroll
                for (int reg = 0; reg < 16; ++reg) { const int i = 32 * qi + (reg & 3) + 8 * (reg >> 2) + 4 * hh;
                    AM[i * 68 + j] = (i > j) ? SC[64 + i] * acc[reg] * SC[192 + i] * rkj * __expf(SC[i] - gcj) : 0.f; }
            } else { const int qj = qd >> 1, qi = qd & 1;
                if (!(qi == 0 && qj == 1)) {
#pragma unroll
                    for (int s = 0; s < 8; ++s) acc = MFMA32(lds_rowfrag(lds + PD_KT, 272, 32 * qj + r, 16 * s + 8 * hh), lds_rowfrag(lds + PD_QT, 272, 32 * qi + r, 16 * s + 8 * hh), acc); }
                const int i = 32 * qi + r; const float gci = SC[i], rqi = SC[128 + i]; bf16* qkg = (bf16*)(ext + 16384);
#pragma unroll
                for (int g4 = 0; g4 < 4; ++g4) { const int j0 = 32 * qj + 8 * g4 + 4 * hh; float v[4];
#pragma unroll
                    for (int e = 0; e < 4; ++e) { const int j = j0 + e; v[e] = (i >= j) ? acc[4 * g4 + e] * rqi * SC[192 + j] * __expf(gci - SC[j]) : 0.f; }
                    u32x2 w; w.x = pk2(v[0], v[1]); w.y = pk2(v[2], v[3]); *(u32x2*)(qkg + i * 64 + j0) = w; } } }
        __syncthreads();
        if (wave != 0)
        for (int p = tid - 64; p < 2048; p += NTHREADS - 64) {
            if (p < 1024) { const int i = p >> 4, d0 = (p & 15) * 8; float f[8]; unpack8(*(const LAS u32x4*)(lds + PD_QT + i * 272 + d0 * 2), f);
                const float sc = SC[128 + i] * SC[256 + i]; f32x4 a = {f[0] * sc, f[1] * sc, f[2] * sc, f[3] * sc}, b = {f[4] * sc, f[5] * sc, f[6] * sc, f[7] * sc};
                *(u32x4*)(pdn + (size_t)(R0 + i) * 3072 + h * 128 + d0) = pack8(a, b); }
            else { const int pp = p - 1024, d = pp >> 3, ig = pp & 7; const LAS bf16* kp = (const LAS bf16*)(lds + PD_KT) + (8 * ig) * 136 + d; float f[8];
#pragma unroll
                for (int e = 0; e < 8; ++e) f[e] = bf2f(kp[e * 136]) * SC[192 + 8 * ig + e];
                f32x4 a = {f[0], f[1], f[2], f[3]}, b = {f[4], f[5], f[6], f[7]};
                *(u32x4*)(pdn + (size_t)(R0 + (d >> 1)) * 3072 + 1024 + h * 128 + (d & 1) * 64 + 8 * ig) = pack8(a, b); }
        }
        if (wave == 0) {
            LAS bf16* TDw = (LAS bf16*)(lds + PD_TD);
            { int vz; asm volatile("v_mov_b32 %0, 0" : "=v"(vz));
                const int blk = lane >> 4, jj = lane & 15; const LAS float* Ab = AM + vz + (16 * blk) * 68 + 16 * blk;
                float t[16]; const float jf = (float)(jj + vz);
#pragma unroll
                for (int i = 0; i < 16; ++i) { float s = 1.f - fminf(fabsf(jf - (float)i), 1.f);
#pragma unroll
                    for (int k4 = 0; k4 < (i + 3) / 4; ++k4) { const f32x4 a = *(const LAS f32x4*)(Ab + i * 68 + 4 * k4);
#pragma unroll
                        for (int cc = 0; cc < 4; ++cc) if (4 * k4 + cc < i) s -= a[cc] * t[4 * k4 + cc]; }
                    t[i] = s; }
#pragma unroll
                for (int i = 0; i < 16; ++i) TDw[(16 * blk + i) * 16 + jj] = f2bf(t[i]); }
        }
        __syncthreads();
        {
            int lane_o = lane; asm volatile("" : "+v"(lane_o)); const int lane = lane_o;
            const LAS bf16* TDw = (const LAS bf16*)(lds + PD_TD);
            const int which = wave >> 2, idx4 = wave & 3, m = lane & 15, kq = lane >> 4;
            bf16x8 Top[4], Aop[4];
#pragma unroll
            for (int bb = 0; bb < 4; ++bb) { const u32x2 lo = *(const LAS u32x2*)(TDw + (16 * bb + m) * 16 + 4 * kq); u32x4 w; w.x = lo.x; w.y = lo.y; w.z = 0u; w.w = 0u; Top[bb] = __builtin_bit_cast(bf16x8, w); }
            { const f32x4 z4 = {0.f, 0.f, 0.f, 0.f};
                const LAS float* r1 = AM + (16 + m) * 68 + 4 * kq; const LAS float* r2 = AM + (32 + m) * 68 + 4 * kq; const LAS float* r3 = AM + (48 + m) * 68 + 4 * kq;
                Aop[0] = packacc(-*(const LAS f32x4*)r1, z4); Aop[1] = packacc(-*(const LAS f32x4*)r2, -*(const LAS f32x4*)(r2 + 16));
                Aop[2] = packacc(-*(const LAS f32x4*)r3, -*(const LAS f32x4*)(r3 + 16)); Aop[3] = packacc(-*(const LAS f32x4*)(r3 + 32), z4); }
            float scv[4][4];
#pragma unroll
            for (int i = 0; i < 4; ++i)
#pragma unroll
                for (int reg = 0; reg < 4; ++reg) { const int row = 16 * i + 4 * kq + reg; scv[i][reg] = which == 0 ? SC[64 + row] : SC[64 + row] * SC[192 + row] * SC[256 + row]; }
            const LAS unsigned char* RT = lds + (which == 0 ? PD_VT : PD_KT);
            LAS bf16* UTw = (LAS bf16*)(lds + PD_UT + idx4 * 4608);
            LAS bf16* WTw = (LAS bf16*)(lds + PD_WS + idx4 * 5120);
            const f32x4 z4 = {0.f, 0.f, 0.f, 0.f};
#pragma unroll
            for (int nt = 0; nt < 2; ++nt) { const int e = 32 * idx4 + 16 * nt + m;
                f32x4 Bv[4];
#pragma unroll
                for (int i = 0; i < 4; ++i)
#pragma unroll
                    for (int reg = 0; reg < 4; ++reg) Bv[i][reg] = bf2f(*(const LAS bf16*)(RT + (16 * i + 4 * kq + reg) * 272 + e * 2)) * scv[i][reg];
                f32x4 U[4];
                U[0] = MFMA16(Top[0], packacc(Bv[0], z4), z4);
                { const f32x4 R = MFMA16(Aop[0], packacc(U[0], z4), Bv[1]); U[1] = MFMA16(Top[1], packacc(R, z4), z4); }
                { const f32x4 R = MFMA16(Aop[1], packacc(U[0], U[1]), Bv[2]); U[2] = MFMA16(Top[2], packacc(R, z4), z4); }
                { f32x4 R = MFMA16(Aop[2], packacc(U[0], U[1]), Bv[3]); R = MFMA16(Aop[3], packacc(U[2], z4), R); U[3] = MFMA16(Top[3], packacc(R, z4), z4); }
                if (which == 0) {
#pragma unroll
                    for (int i = 0; i < 4; ++i) { u32x2 w; w.x = pk2(U[i][0], U[i][1]); w.y = pk2(U[i][2], U[i][3]); *(LAS u32x2*)(UTw + (16 * nt + m) * 72 + 16 * i + 4 * kq) = w; }
                } else {
#pragma unroll
                    for (int i = 0; i < 4; ++i)
#pragma unroll
                        for (int reg = 0; reg < 4; ++reg) WTw[(16 * i + 4 * kq + reg) * 40 + 16 * nt + m] = f2bf(-U[i][reg]);
                } }
            if (which == 0) { LDS_WAIT();
#pragma unroll
                for (int it4 = 0; it4 < 4; ++it4) { const int rl = 8 * it4 + (lane >> 3), pc = lane & 7, e = 32 * idx4 + rl;
                    *(u32x4*)(pdn + (size_t)(R0 + (e >> 1)) * 3072 + 2048 + h * 128 + (e & 1) * 64 + 8 * pc) = *(const LAS u32x4*)(UTw + rl * 72 + 8 * pc); } }
            if (which == 1) { LDS_WAIT(); bf16* wn = (bf16*)ext;
#pragma unroll
                for (int it4 = 0; it4 < 4; ++it4) { const int cc = 16 * it4 + (lane >> 2), pc = lane & 3;
                    *(u32x4*)(wn + cc * 128 + 32 * idx4 + 8 * pc) = *(const LAS u32x4*)(WTw + cc * 40 + 8 * pc); } }
        }
        __syncthreads();
    }
#undef PDN_PREFETCH
#undef PDN_ITEM
}

constexpr int WLDS = 20480;
DI void prep_gla_wave(const Params& P, LAS unsigned char* wl, int item, int lane) {
    const int h = item & 3, gch = item >> 2, c = gch % NCH; const int R0 = gch * 64;
    bf16* pg = (bf16*)(P.ws + WS_PGLA); const float* small = (const float*)(P.ws + WS_SMALL);
    const int d0 = 2 * lane;
    f32x2_t wa[16];
#pragma unroll
    for (int r = 0; r < 16; ++r) wa[r] = *(const f32x2_t*)(P.in[9] + r * 512 + h * 128 + d0);
    const f32x2_t ba = *(const f32x2_t*)(P.in[10] + h * 128 + d0);
    float b0 = 0.f, b1 = 0.f;
    bf16* qrow = pg + (size_t)R0 * 2048 + h * 128 + d0;
    bf16* kt0 = pg + (size_t)(R0 + lane) * 2048 + 512 + h * 128;
    f32x4 lrv[4];
#pragma unroll
    for (int q = 0; q < 4; ++q) lrv[q] = *(const f32x4*)(small + (size_t)(R0 + lane) * 32 + 16 + 4 * q);
    int vz; asm volatile("v_mov_b32 %0, 0" : "=v"(vz));
    const LAS float* LRB = (const LAS float*)(wl + 17408) + vz;
#pragma unroll
    for (int i8 = 0; i8 < 8; ++i8) {
        unsigned qv[8], kv[8];
#pragma unroll
        for (int e = 0; e < 8; ++e) { const bf16* p = qrow + (size_t)(8 * i8 + e) * 2048; qv[e] = *(const unsigned*)p; kv[e] = *(const unsigned*)(p + 512); }
        if ((lane >> 3) == i8) {
#pragma unroll
            for (int q = 0; q < 4; ++q) *(LAS f32x4*)((LAS float*)(wl + 17408) + (lane & 7) * 16 + 4 * q) = lrv[q]; }
        asm volatile("" ::: "memory");
        float ka0[8], ka1[8];
#pragma unroll
        for (int e = 0; e < 8; ++e) { const int i = 8 * i8 + e;
            f32x2_t xx = ba;
#pragma unroll
            for (int r4 = 0; r4 < 4; ++r4) { const f32x4 l = *(const LAS f32x4*)(LRB + e * 16 + 4 * r4);
#pragma unroll
                for (int rr = 0; rr < 4; ++rr) { const f32x2_t lb = {l[rr], l[rr]}; xx = __builtin_elementwise_fma(lb, wa[4 * r4 + rr], xx); } }
            const float x0 = xx[0], x1 = xx[1];
            const bool pad = (c == 0 && i < 48);
            b0 += pad ? 0.f : logsigmoidf_(x0) * (1.f / 16.f); b1 += pad ? 0.f : logsigmoidf_(x1) * (1.f / 16.f);
            const float E0 = __expf(b0), E1 = __expf(b1), I0 = __builtin_amdgcn_rcpf(E0), I1 = __builtin_amdgcn_rcpf(E1);
            const unsigned q = pk2(bflo(qv[e]) * 0.08838834764831845f * E0, bfhi(qv[e]) * 0.08838834764831845f * E1);
            *(unsigned*)(qrow + (size_t)i * 2048) = q;
            ka0[e] = bflo(kv[e]) * I0; ka1[e] = bfhi(kv[e]) * I1;
            *(LAS unsigned*)(wl + i * 272 + 4 * lane) = pk2(ka0[e], ka1[e]); }
    }
    asm volatile("" ::: "memory");
#pragma unroll
    for (int i8 = 0; i8 < 8; ++i8) { unsigned v[8];
#pragma unroll
        for (int e = 0; e < 8; ++e) v[e] = *(const LAS unsigned*)(wl + (8 * i8 + e) * 272 + 4 * lane);
        u32x4 w0, w1;
        w0.x = (v[0] & 0xffffu) | (v[1] << 16); w0.y = (v[2] & 0xffffu) | (v[3] << 16); w0.z = (v[4] & 0xffffu) | (v[5] << 16); w0.w = (v[6] & 0xffffu) | (v[7] << 16);
        w1.x = (v[0] >> 16) | (v[1] & 0xffff0000u); w1.y = (v[2] >> 16) | (v[3] & 0xffff0000u); w1.z = (v[4] >> 16) | (v[5] & 0xffff0000u); w1.w = (v[6] >> 16) | (v[7] & 0xffff0000u);
        *(u32x4*)(kt0 + 8 * i8) = w0; *(u32x4*)(kt0 + 64 + 8 * i8) = w1; }
    { f32x2_t eb = {__expf(b0), __expf(b1)}; *(f32x2_t*)((float*)(P.ws + WS_EBL) + (size_t)item * 128 + d0) = eb; }
    const int r = lane & 31, hh = lane >> 5;
    bf16x8 kf[2][8];
#pragma unroll
    for (int qj = 0; qj < 2; ++qj)
#pragma unroll
        for (int s = 0; s < 8; ++s) kf[qj][s] = lds_rowfrag(wl, 272, 32 * qj + r, 16 * s + 8 * hh);
    asm volatile("s_waitcnt vmcnt(0)" ::: "memory");
#pragma unroll
    for (int i16 = 0; i16 < 4; ++i16) { unsigned qq[16];
#pragma unroll
        for (int e = 0; e < 16; ++e) qq[e] = __hip_atomic_load((const unsigned*)(qrow + (size_t)(16 * i16 + e) * 2048), __ATOMIC_RELAXED, __HIP_MEMORY_SCOPE_AGENT);
#pragma unroll
        for (int e = 0; e < 16; ++e) *(LAS unsigned*)(wl + (16 * i16 + e) * 272 + 4 * lane) = qq[e]; }
    bf16* att = (bf16*)(P.ws + WS_ATT + (size_t)item * 8192);
#pragma unroll
    for (int qd3 = 0; qd3 < 3; ++qd3) { const int qj = qd3 >> 1, qi = (qd3 + 1) >> 1;
        f32x16 acc;
#pragma unroll
        for (int e = 0; e < 16; ++e) acc[e] = 0.f;
#pragma unroll
        for (int s = 0; s < 8; ++s) acc = MFMA32(kf[qj][s], lds_rowfrag(wl, 272, 32 * qi + r, 16 * s + 8 * hh), acc);
        const int i = 32 * qi + r;
#pragma unroll
        for (int g4 = 0; g4 < 4; ++g4) { const int j0 = 32 * qj + 8 * g4 + 4 * hh; float v[4];
#pragma unroll
            for (int e = 0; e < 4; ++e) v[e] = (i >= j0 + e) ? acc[4 * g4 + e] : 0.f;
            u32x2 w; w.x = pk2(v[0], v[1]); w.y = pk2(v[2], v[3]); *(u32x2*)(att + i * 64 + j0) = w; } }
#pragma unroll
    for (int g4 = 0; g4 < 4; ++g4) { u32x2 z = {0u, 0u}; *(u32x2*)(att + r * 64 + 32 + 8 * g4 + 4 * hh) = z; }
    asm volatile("" ::: "memory");
}
DI void prep_gla_phase(const Params& P, LAS unsigned char* lds) {
    int tid_o = threadIdx.x; asm volatile("" : "+v"(tid_o)); const int tid = tid_o, lane = tid & 63, wave = __builtin_amdgcn_readfirstlane(tid >> 6);
    LAS unsigned char* wl = lds + wave * WLDS;
    for (int item = blockIdx.x + gridDim.x * wave; item < NIT_GLA; item += gridDim.x * 8) prep_gla_wave(P, wl, item, lane);
}

DI bf16x8 frag2(const LAS unsigned char* tile, int pitchB, int row, int c0) {
    const u32x2 lo = *(const LAS u32x2*)(tile + row * pitchB + c0 * 2), hi = *(const LAS u32x2*)(tile + row * pitchB + (c0 + 16) * 2);
    u32x4 w; w.x = lo.x; w.y = lo.y; w.z = hi.x; w.w = hi.y; return __builtin_bit_cast(bf16x8, w);
}
constexpr int SC_WN = 0, SC_QD = 17408, SC_QK = 34816, SC_KT = 44032, SC_BUF = 62464, SC_DK = 124928, SC_SSQ = 125952;

DI bf16x8 frag32(const LAS unsigned char* tile, int pitchB, int row, int k0, int hh) {
    const u32x2 lo = *(const LAS u32x2*)(tile + row * pitchB + (k0 + 4 * hh) * 2), hi = *(const LAS u32x2*)(tile + row * pitchB + (k0 + 8 + 4 * hh) * 2);
    u32x4 w; w.x = lo.x; w.y = lo.y; w.z = hi.x; w.w = hi.y; return __builtin_bit_cast(bf16x8, w);
}
DI bf16x8 packacc8(const f32x16& x, int h2) { u32x4 w; w.x = pk2(x[8 * h2], x[8 * h2 + 1]); w.y = pk2(x[8 * h2 + 2], x[8 * h2 + 3]); w.z = pk2(x[8 * h2 + 4], x[8 * h2 + 5]); w.w = pk2(x[8 * h2 + 6], x[8 * h2 + 7]); return __builtin_bit_cast(bf16x8, w); }

#define SBAR() asm volatile("s_waitcnt lgkmcnt(0)\n\ts_barrier" ::: "memory")
DI void scan_dn_item(const Params& P, LAS unsigned char* lds, int item) {
    int tid_o = threadIdx.x; asm volatile("" : "+v"(tid_o)); const int tid = tid_o, lane = tid & 63, wave = __builtin_amdgcn_readfirstlane(tid >> 6);
    const int b = item >> 3, h = item & 7, r = lane & 31, hh = lane >> 5, e0 = 32 * (wave & 3);
    const bool comp = wave < 4; const int lt = tid - 256;
    bf16* pdn = (bf16*)(P.ws + WS_PDN); float* ssqg = (float*)(P.ws + WS_SSQ_DN);
#define SDN_LOAD(cc, st, stdk) do { const int gch_ = b * NCH + (cc); const int R0_ = gch_ * 64; const unsigned char* ext_ = P.ws + WS_EXT + (size_t)(gch_ * 8 + h) * 24576; \
        _Pragma("unroll") for (int j_ = 0; j_ < 4; ++j_) { const int p_ = lt + 256 * j_; st[j_] = *(const u32x4*)(ext_ + (size_t)p_ * 16); \
            st[4 + j_] = *(const u32x4*)(pdn + (size_t)(R0_ + (p_ >> 4)) * 3072 + h * 128 + (p_ & 15) * 8); \
            const int d_ = p_ >> 3; st[10 + j_] = *(const u32x4*)(pdn + (size_t)(R0_ + (d_ >> 1)) * 3072 + 1024 + h * 128 + (d_ & 1) * 64 + (p_ & 7) * 8); } \
        _Pragma("unroll") for (int j_ = 0; j_ < 2; ++j_) { const int p_ = lt + 256 * j_; st[8 + j_] = *(const u32x4*)(ext_ + 16384 + (size_t)p_ * 16); } \
        if (lt < 20) stdk = *(const u32x4*)((const float*)(P.ws + WS_SC_DN) + (size_t)(gch_ * 8 + h) * 80 + lt * 4); } while (0)
#define SDN_STORE(bb, st, stdk) do { LAS unsigned char* B_ = lds + (bb) * SC_BUF; \
        _Pragma("unroll") for (int j_ = 0; j_ < 4; ++j_) { const int p_ = lt + 256 * j_; *(LAS u32x4*)(B_ + SC_WN + (p_ >> 4) * 272 + (p_ & 15) * 16) = st[j_]; *(LAS u32x4*)(B_ + SC_QD + (p_ >> 4) * 272 + (p_ & 15) * 16) = st[4 + j_]; \
            *(LAS u32x4*)(B_ + SC_KT + (p_ >> 3) * 144 + (p_ & 7) * 16) = st[10 + j_]; } \
        _Pragma("unroll") for (int j_ = 0; j_ < 2; ++j_) { const int p_ = lt + 256 * j_; *(LAS u32x4*)(B_ + SC_QK + (p_ >> 3) * 144 + (p_ & 7) * 16) = st[8 + j_]; } \
        if (lt < 20) *(LAS u32x4*)(lds + SC_DK + (bb) * 512 + lt * 16) = stdk; } while (0)
#define SDN_ULOAD(cc) do { const int R0_ = (b * NCH + (cc)) * 64; const int e_ = e0 + r; \
        _Pragma("unroll") for (int q_ = 0; q_ < 8; ++q_) su[q_] = *(const u32x2*)(pdn + (size_t)(R0_ + (e_ >> 1)) * 3072 + 2048 + h * 128 + (e_ & 1) * 64 + 32 * (q_ >> 2) + 8 * (q_ & 3) + 4 * hh); } while (0)
    if (!comp) {
        u32x4 sa[14], sb[14], sc[14]; u32x4 da, db, dc;
        SDN_LOAD(0, sa, da); SDN_STORE(0, sa, da);
        SDN_LOAD(1, sb, db); SDN_LOAD(2, sc, dc);
        SBAR();
#define SDN_STEP(i, SL, DL, SS, DS) do { const int bb_ = (i) & 1; const int R0_s = (b * NCH + (i)) * 64; \
            if ((i) > 0 && lt < 64) { const LAS float* sp = (const LAS float*)(lds + SC_SSQ + (bb_ ^ 1) * 2048); ssqg[(size_t)(R0_s - 64 + lt) * 8 + h] = (sp[lt] + sp[64 + lt]) + (sp[128 + lt] + sp[192 + lt]); } \
            if ((i) + 3 < NCH) SDN_LOAD((i) + 3, SL, DL); \
            if ((i) + 1 < NCH) SDN_STORE(bb_ ^ 1, SS, DS); \
            SBAR(); } while (0)
        for (int c3 = 0; c3 < NCH; c3 += 3) { SDN_STEP(c3, sa, da, sb, db); SDN_STEP(c3 + 1, sb, db, sc, dc); SDN_STEP(c3 + 2, sc, dc, sa, da); }
#undef SDN_STEP
        if (lt < 64) { const LAS float* sp = (const LAS float*)(lds + SC_SSQ + ((NCH - 1) & 1) * 2048); ssqg[(size_t)((b * NCH + NCH - 1) * 64 + lt) * 8 + h] = (sp[lt] + sp[64 + lt]) + (sp[128 + lt] + sp[192 + lt]); }
        SBAR();
    } else {
        f32x16 S[4];
#pragma unroll
        for (int i = 0; i < 4; ++i)
#pragma unroll
            for (int e = 0; e < 16; ++e) S[i][e] = 0.f;
        u32x2 su[8], ucur[8], unx[8];
        SDN_ULOAD(0);
#pragma unroll
        for (int q = 0; q < 8; ++q) ucur[q] = su[q];
        SDN_ULOAD(1);
#pragma unroll
        for (int q = 0; q < 8; ++q) unx[q] = su[q];
        SBAR();
        for (int c = 0; c < NCH; ++c) {
            const int bb = c & 1; const LAS unsigned char* B = lds + bb * SC_BUF; const LAS float* DK = (const LAS float*)(lds + SC_DK + bb * 512);
            const int R0 = (b * NCH + c) * 64;
            if (c + 2 < NCH) SDN_ULOAD(c + 2);
            f32x16 vn[2], oT[2];
#pragma unroll
            for (int mi = 0; mi < 2; ++mi)
#pragma unroll
                for (int g4 = 0; g4 < 4; ++g4) { const u32x2 u = ucur[4 * mi + g4]; vn[mi][4 * g4] = bflo(u.x); vn[mi][4 * g4 + 1] = bfhi(u.x); vn[mi][4 * g4 + 2] = bflo(u.y); vn[mi][4 * g4 + 3] = bfhi(u.y);
                    oT[mi][4 * g4] = 0.f; oT[mi][4 * g4 + 1] = 0.f; oT[mi][4 * g4 + 2] = 0.f; oT[mi][4 * g4 + 3] = 0.f; }
            bf16x8 fw[2][2], fq[2][2];
#pragma unroll
            for (int mi = 0; mi < 2; ++mi) { fw[0][mi] = frag32(B + SC_WN, 272, 32 * mi + r, 0, hh); fq[0][mi] = frag32(B + SC_QD, 272, 32 * mi + r, 0, hh); }
#pragma unroll
            for (int s = 0; s < 8; ++s) { const int cu = s & 1, nx = cu ^ 1;
                if (s < 7) {
#pragma unroll
                    for (int mi = 0; mi < 2; ++mi) { fw[nx][mi] = frag32(B + SC_WN, 272, 32 * mi + r, 16 * (s + 1), hh); fq[nx][mi] = frag32(B + SC_QD, 272, 32 * mi + r, 16 * (s + 1), hh); } }
                const bf16x8 Sf = packacc8(S[s >> 1], s & 1);
                __builtin_amdgcn_sched_barrier(0);
#pragma unroll
                for (int mi = 0; mi < 2; ++mi) { vn[mi] = MFMA32(fw[cu][mi], Sf, vn[mi]); oT[mi] = MFMA32(Sf, fq[cu][mi], oT[mi]); }
                __builtin_amdgcn_sched_barrier(0); }
            bf16x8 fk[4][2];
#pragma unroll
            for (int t = 0; t < 4; ++t)
#pragma unroll
                for (int ni = 0; ni < 2; ++ni) fk[t][ni] = frag32(B + SC_QK, 144, 32 * ni + r, 16 * t, hh);
            bf16x8 vb[4], vd[4];
#pragma unroll
            for (int t = 0; t < 4; ++t) { const int mi = t >> 1, h2 = t & 1; vb[t] = packacc8(vn[mi], h2);
                const f32x4 d0 = *(const LAS f32x4*)(DK + 32 * mi + 16 * h2 + 4 * hh), d1 = *(const LAS f32x4*)(DK + 32 * mi + 16 * h2 + 8 + 4 * hh);
                u32x4 w; w.x = pk2(vn[mi][8 * h2] * d0[0], vn[mi][8 * h2 + 1] * d0[1]); w.y = pk2(vn[mi][8 * h2 + 2] * d0[2], vn[mi][8 * h2 + 3] * d0[3]);
                w.z = pk2(vn[mi][8 * h2 + 4] * d1[0], vn[mi][8 * h2 + 5] * d1[1]); w.w = pk2(vn[mi][8 * h2 + 6] * d1[2], vn[mi][8 * h2 + 7] * d1[3]); vd[t] = __builtin_bit_cast(bf16x8, w); }
            const float egl = DK[64];
            bf16x8 ft[2][4];
#pragma unroll
            for (int t = 0; t < 4; ++t) ft[0][t] = frag32(B + SC_KT, 144, r, 16 * t, hh);
            __builtin_amdgcn_sched_barrier(0);
#pragma unroll
            for (int t = 0; t < 4; ++t)
#pragma unroll
                for (int ni = 0; ni < 2; ++ni) oT[ni] = MFMA32(vb[t], fk[t][ni], oT[ni]);
            __builtin_amdgcn_sched_barrier(0);
#pragma unroll
            for (int db = 0; db < 4; ++db) { const int cu = db & 1, nx = cu ^ 1;
                if (db < 3) {
#pragma unroll
                    for (int t = 0; t < 4; ++t) ft[nx][t] = frag32(B + SC_KT, 144, 32 * (db + 1) + r, 16 * t, hh); }
                S[db] = S[db] * egl;
                __builtin_amdgcn_sched_barrier(0);
#pragma unroll
                for (int t = 0; t < 4; ++t) S[db] = MFMA32(ft[cu][t], vd[t], S[db]);
                __builtin_amdgcn_sched_barrier(0); }
            LAS float* sq = (LAS float*)(lds + SC_SSQ + bb * 2048);
#pragma unroll
            for (int ni = 0; ni < 2; ++ni) { float s = 0.f;
#pragma unroll
                for (int g4 = 0; g4 < 4; ++g4) { u32x2 w; w.x = pk2(oT[ni][4 * g4], oT[ni][4 * g4 + 1]); w.y = pk2(oT[ni][4 * g4 + 2], oT[ni][4 * g4 + 3]);
                    *(u32x2*)(pdn + (size_t)(R0 + 32 * ni + r) * 3072 + h * 128 + e0 + 8 * g4 + 4 * hh) = w;
                    s += (oT[ni][4 * g4] * oT[ni][4 * g4] + oT[ni][4 * g4 + 1] * oT[ni][4 * g4 + 1]) + (oT[ni][4 * g4 + 2] * oT[ni][4 * g4 + 2] + oT[ni][4 * g4 + 3] * oT[ni][4 * g4 + 3]); }
                s += __shfl_xor(s, 32);
                if (hh == 0) sq[wave * 64 + 32 * ni + r] = s; }
#pragma unroll
            for (int q = 0; q < 8; ++q) { ucur[q] = unx[q]; unx[q] = su[q]; }
            SBAR();
        }
        SBAR();
    }
#undef SDN_LOAD
#undef SDN_STORE
#undef SDN_ULOAD
}

constexpr int SG_QD = 0, SG_ATT = 17408, SG_KT = 26624, SG_V = 45056;
DI void scan_gla_item(const Params& P, LAS unsigned char* lds, int item) {
    int tid_o = threadIdx.x; asm volatile("" : "+v"(tid_o)); const int tid = tid_o, lane = tid & 63, wave = __builtin_amdgcn_readfirstlane(tid >> 6);
    const int half = item & 1, h = (item >> 1) & 3, b = item >> 3, r = lane & 31, hh = lane >> 5, e0 = 32 * (wave & 3);
    const bool comp = wave < 4; const int lt = tid - 256;
    bf16* pg = (bf16*)(P.ws + WS_PGLA); float* ssqg = (float*)(P.ws + WS_SSQ_GLA);
    const int vcol = 1024 + h * 256 + half * 128;
#define SGL_LOAD(cc, st, ste) do { const int gch_ = b * NCH + (cc); const int R0_ = gch_ * 64; const int it_ = gch_ * 4 + h; \
        _Pragma("unroll") for (int j_ = 0; j_ < 4; ++j_) { const int p_ = lt + 256 * j_; st[j_] = *(const u32x4*)(pg + (size_t)(R0_ + (p_ >> 4)) * 2048 + h * 128 + (p_ & 15) * 8); \
            const int d_ = p_ >> 3; st[4 + j_] = *(const u32x4*)(pg + (size_t)(R0_ + (d_ >> 1)) * 2048 + 512 + h * 128 + (d_ & 1) * 64 + (p_ & 7) * 8); \
            st[8 + j_] = *(const u32x4*)(pg + (size_t)(R0_ + (p_ >> 4)) * 2048 + vcol + (p_ & 15) * 8); } \
        _Pragma("unroll") for (int j_ = 0; j_ < 2; ++j_) { const int p_ = lt + 256 * j_; st[12 + j_] = *(const u32x4*)(P.ws + WS_ATT + (size_t)it_ * 8192 + (size_t)p_ * 16); } \
        if (lt < 32) ste = *(const u32x4*)((const float*)(P.ws + WS_EBL) + (size_t)it_ * 128 + lt * 4); } while (0)
#define SGL_STORE(bb, st, ste) do { LAS unsigned char* B_ = lds + (bb) * SC_BUF; \
        _Pragma("unroll") for (int j_ = 0; j_ < 4; ++j_) { const int p_ = lt + 256 * j_; *(LAS u32x4*)(B_ + SG_QD + (p_ >> 4) * 272 + (p_ & 15) * 16) = st[j_]; \
            *(LAS u32x4*)(B_ + SG_KT + (p_ >> 3) * 144 + (p_ & 7) * 16) = st[4 + j_]; *(LAS u32x4*)(B_ + SG_V + (p_ >> 4) * 272 + (p_ & 15) * 16) = st[8 + j_]; } \
        _Pragma("unroll") for (int j_ = 0; j_ < 2; ++j_) { const int p_ = lt + 256 * j_; *(LAS u32x4*)(B_ + SG_ATT + (p_ >> 3) * 144 + (p_ & 7) * 16) = st[12 + j_]; } \
        if (lt < 32) *(LAS u32x4*)(lds + SC_DK + (bb) * 512 + lt * 16) = ste; } while (0)
    if (!comp) {
        u32x4 sa[14], sb[14], sc[14]; u32x4 da, db, dc;
        SGL_LOAD(0, sa, da); SGL_STORE(0, sa, da);
        SGL_LOAD(1, sb, db); SGL_LOAD(2, sc, dc);
        SBAR();
#define SGL_STEP(i, SL, DL, SS, DS) do { const int bb_ = (i) & 1; const int R0_s = (b * NCH + (i)) * 64; \
            if ((i) > 0 && lt < 64) { const LAS float* sp = (const LAS float*)(lds + SC_SSQ + (bb_ ^ 1) * 2048); ssqg[(size_t)(R0_s - 64 + lt) * 8 + h * 2 + half] = (sp[lt] + sp[64 + lt]) + (sp[128 + lt] + sp[192 + lt]); } \
            if ((i) + 3 < NCH) SGL_LOAD((i) + 3, SL, DL); \
            if ((i) + 1 < NCH) SGL_STORE(bb_ ^ 1, SS, DS); \
            SBAR(); } while (0)
        for (int c3 = 0; c3 < NCH; c3 += 3) { SGL_STEP(c3, sa, da, sb, db); SGL_STEP(c3 + 1, sb, db, sc, dc); SGL_STEP(c3 + 2, sc, dc, sa, da); }
#undef SGL_STEP
        if (lt < 64) { const LAS float* sp = (const LAS float*)(lds + SC_SSQ + ((NCH - 1) & 1) * 2048); ssqg[(size_t)((b * NCH + NCH - 1) * 64 + lt) * 8 + h * 2 + half] = (sp[lt] + sp[64 + lt]) + (sp[128 + lt] + sp[192 + lt]); }
        SBAR();
    } else {
        f32x16 S[4];
#pragma unroll
        for (int i = 0; i < 4; ++i)
#pragma unroll
            for (int e = 0; e < 16; ++e) S[i][e] = 0.f;
        SBAR();
        for (int c = 0; c < NCH; ++c) {
            const int bb = c & 1; const LAS unsigned char* B = lds + bb * SC_BUF; const LAS float* EB = (const LAS float*)(lds + SC_DK + bb * 512);
            const int R0 = (b * NCH + c) * 64;
            f32x16 oT[2];
#pragma unroll
            for (int ni = 0; ni < 2; ++ni)
#pragma unroll
                for (int e = 0; e < 16; ++e) oT[ni][e] = 0.f;
            bf16x8 fq[2][2];
#pragma unroll
            for (int ni = 0; ni < 2; ++ni) fq[0][ni] = frag32(B + SG_QD, 272, 32 * ni + r, 0, hh);
            bf16x8 vf[4], fk[4][2];
#pragma unroll
            for (int t = 0; t < 4; ++t) { const LAS bf16* vp = (const LAS bf16*)(B + SG_V) + (16 * t + 4 * hh) * 136 + e0 + r; u32x4 w;
                w.x = (unsigned)vp[0] | ((unsigned)vp[136] << 16); w.y = (unsigned)vp[2 * 136] | ((unsigned)vp[3 * 136] << 16);
                w.z = (unsigned)vp[8 * 136] | ((unsigned)vp[9 * 136] << 16); w.w = (unsigned)vp[10 * 136] | ((unsigned)vp[11 * 136] << 16);
                vf[t] = __builtin_bit_cast(bf16x8, w); }
#pragma unroll
            for (int s = 0; s < 8; ++s) { const int cu = s & 1, nx = cu ^ 1;
                if (s < 7) {
#pragma unroll
                    for (int ni = 0; ni < 2; ++ni) fq[nx][ni] = frag32(B + SG_QD, 272, 32 * ni + r, 16 * (s + 1), hh); }
                const bf16x8 Sf = packacc8(S[s >> 1], s & 1);
                __builtin_amdgcn_sched_barrier(0);
#pragma unroll
                for (int ni = 0; ni < 2; ++ni) oT[ni] = MFMA32(Sf, fq[cu][ni], oT[ni]);
                __builtin_amdgcn_sched_barrier(0); }
#pragma unroll
            for (int t = 0; t < 4; ++t)
#pragma unroll
                for (int ni = 0; ni < 2; ++ni) fk[t][ni] = frag32(B + SG_ATT, 144, 32 * ni + r, 16 * t, hh);
            bf16x8 ft[2][4];
#pragma unroll
            for (int t = 0; t < 4; ++t) ft[0][t] = frag32(B + SG_KT, 144, r, 16 * t, hh);
            __builtin_amdgcn_sched_barrier(0);
#pragma unroll
            for (int t = 0; t < 4; ++t)
#pragma unroll
                for (int ni = 0; ni < 2; ++ni) oT[ni] = MFMA32(vf[t], fk[t][ni], oT[ni]);
            __builtin_amdgcn_sched_barrier(0);
#pragma unroll
            for (int db = 0; db < 4; ++db) { const int cu = db & 1, nx = cu ^ 1;
                if (db < 3) {
#pragma unroll
                    for (int t = 0; t < 4; ++t) ft[nx][t] = frag32(B + SG_KT, 144, 32 * (db + 1) + r, 16 * t, hh); }
                __builtin_amdgcn_sched_barrier(0);
#pragma unroll
                for (int t = 0; t < 4; ++t) S[db] = MFMA32(ft[cu][t], vf[t], S[db]);
                __builtin_amdgcn_sched_barrier(0);
#pragma unroll
                for (int g4 = 0; g4 < 4; ++g4) { const f32x4 eb = *(const LAS f32x4*)(EB + 32 * db + 8 * g4 + 4 * hh);
                    S[db][4 * g4] *= eb[0]; S[db][4 * g4 + 1] *= eb[1]; S[db][4 * g4 + 2] *= eb[2]; S[db][4 * g4 + 3] *= eb[3]; } }
            LAS float* sq = (LAS float*)(lds + SC_SSQ + bb * 2048);
#pragma unroll
            for (int ni = 0; ni < 2; ++ni) { float s = 0.f;
#pragma unroll
                for (int g4 = 0; g4 < 4; ++g4) { u32x2 w; w.x = pk2(oT[ni][4 * g4], oT[ni][4 * g4 + 1]); w.y = pk2(oT[ni][4 * g4 + 2], oT[ni][4 * g4 + 3]);
                    *(u32x2*)(pg + (size_t)(R0 + 32 * ni + r) * 2048 + vcol + e0 + 8 * g4 + 4 * hh) = w;
                    s += (oT[ni][4 * g4] * oT[ni][4 * g4] + oT[ni][4 * g4 + 1] * oT[ni][4 * g4 + 1]) + (oT[ni][4 * g4 + 2] * oT[ni][4 * g4 + 2] + oT[ni][4 * g4 + 3] * oT[ni][4 * g4 + 3]); }
                s += __shfl_xor(s, 32);
                if (hh == 0) sq[wave * 64 + 32 * ni + r] = s; }
            SBAR();
        }
        SBAR();
    }
#undef SGL_LOAD
#undef SGL_STORE
}

constexpr int RT_WR = 0, RT_WBUF = 43520, RT_LG = 87040, RT_RS = 128000, RT_HS = 128512;
DI void router_group(const Params& P, LAS unsigned char* lds, int rg) {
    int tid_o = threadIdx.x; asm volatile("" : "+v"(tid_o)); const int tid = tid_o, lane = tid & 63, wave = __builtin_amdgcn_readfirstlane(tid >> 6);
    const unsigned char* wsrc = P.ws + WS_WRT; unsigned char* xb8 = P.ws + WS_XB;
    LAS float* LG = (LAS float*)(lds + RT_LG); LAS float* RS = (LAS float*)(lds + RT_RS); LAS int* HS = (LAS int*)(lds + RT_HS);
    const int i = lane & 15, kq = lane >> 4; const int row = rg * 128 + wave * 16 + i;
    const bf16* hhi = H1HI((const bf16*)(P.ws + WS_PGLA), row) + 8 * kq; const bf16* hlo = (const bf16*)P.out + (size_t)row * 1024 + 8 * kq;
    if (tid < 64) HS[tid] = 0;
    LAS float* BI = (LAS float*)(lds + RT_HS + 256);
    if (tid >= 64 && tid < 136) BI[tid - 64] = (tid < 72) ? P.in[16][tid - 64] : P.in[18][tid - 72];
    f32x4 acc[5];
#pragma unroll
    for (int cb = 0; cb < 5; ++cb) acc[cb] = (f32x4){0.f, 0.f, 0.f, 0.f};
    float ssq = 0.f;
    u32x4 wst[5]; u32x4 aA[8], aB[8];
    int soff[5], doff[5];
#pragma unroll
    for (int q = 0; q < 5; ++q) { const int p = tid + 512 * q, hl = p / 1280, rem = p - hl * 1280, n = rem >> 4, c16 = rem & 15; soff[q] = (hl * 80 + n) * 2048 + c16 * 16; doff[q] = (hl * 80 + n) * 272 + c16 * 16; }
#pragma unroll
    for (int q = 0; q < 5; ++q) wst[q] = *(const u32x4*)(wsrc + soff[q]);
#pragma unroll
    for (int t = 0; t < 8; ++t) aA[t] = *(const u32x4*)(((t & 1) ? hlo : hhi) + 32 * (t >> 1));
#pragma unroll
    for (int t = 0; t < 8; ++t) aB[t] = *(const u32x4*)(((t & 1) ? hlo : hhi) + 128 + 32 * (t >> 1));
#pragma unroll
    for (int q = 0; q < 5; ++q) *(LAS u32x4*)(lds + RT_WR + doff[q]) = wst[q];
#define RT_CHUNK(A_, kc_) { const int kc = (kc_); \
        asm volatile("s_waitcnt lgkmcnt(0)\n\ts_barrier" ::: "memory"); \
        const LAS unsigned char* WB = lds + RT_WR + (kc & 1) * RT_WBUF; \
        if (kc < 7) { _Pragma("unroll") for (int q = 0; q < 5; ++q) wst[q] = *(const u32x4*)(wsrc + soff[q] + (kc + 1) * 256); } \
        _Pragma("unroll") for (int s = 0; s < 4; ++s) { const u32x4 hw = A_[2 * s], lw = A_[2 * s + 1]; float hf[8], lf[8]; unpack8(hw, hf); unpack8(lw, lf); \
            if (kc + 2 < 8) { A_[2 * s] = *(const u32x4*)(hhi + (kc + 2) * 128 + 32 * s); A_[2 * s + 1] = *(const u32x4*)(hlo + (kc + 2) * 128 + 32 * s); } \
            const f32x4 x0 = {hf[0] + lf[0], hf[1] + lf[1], hf[2] + lf[2], hf[3] + lf[3]}, x1 = {hf[4] + lf[4], hf[5] + lf[5], hf[6] + lf[6], hf[7] + lf[7]}; \
            ssq += (x0[0] * x0[0] + x0[1] * x0[1]) + (x0[2] * x0[2] + x0[3] * x0[3]) + (x1[0] * x1[0] + x1[1] * x1[1]) + (x1[2] * x1[2] + x1[3] * x1[3]); \
            { u32x2 w8; w8.x = pk4_fp8(x0[0], x0[1], x0[2], x0[3]); w8.y = pk4_fp8(x1[0], x1[1], x1[2], x1[3]); *(u32x2*)(xb8 + (size_t)row * 1024 + kc * 128 + 32 * s + 8 * kq) = w8; } \
            const bf16x8 ah = __builtin_bit_cast(bf16x8, hw), al = __builtin_bit_cast(bf16x8, lw); \
            _Pragma("unroll") for (int cb = 0; cb < 5; ++cb) { const bf16x8 bh = *(const LAS bf16x8*)(WB + (16 * cb + i) * 272 + (32 * s + 8 * kq) * 2), bl = *(const LAS bf16x8*)(WB + (80 + 16 * cb + i) * 272 + (32 * s + 8 * kq) * 2); \
                acc[cb] = MFMA16(ah, bh, acc[cb]); acc[cb] = MFMA16(ah, bl, acc[cb]); acc[cb] = MFMA16(al, bh, acc[cb]); } } \
        if (kc < 7) { _Pragma("unroll") for (int q = 0; q < 5; ++q) *(LAS u32x4*)(lds + RT_WR + ((kc + 1) & 1) * RT_WBUF + doff[q]) = wst[q]; } }
#pragma nounroll
    for (int k2 = 0; k2 < 8; k2 += 2) { RT_CHUNK(aA, k2) RT_CHUNK(aB, k2 + 1) }
#undef RT_CHUNK
    ssq += __shfl_xor(ssq, 16); ssq += __shfl_xor(ssq, 32);
    if (kq == 0) RS[wave * 16 + i] = rsqrtf(ssq * (1.f / 1024.f) + EPS);
#pragma unroll
    for (int cb = 0; cb < 5; ++cb)
#pragma unroll
        for (int reg = 0; reg < 4; ++reg) LG[(wave * 16 + 4 * kq + reg) * 80 + 16 * cb + i] = acc[cb][reg];
    __syncthreads();
    if (tid < 128) {
        const int t = rg * 128 + tid; const float rs = RS[tid]; const LAS float* lg = LG + tid * 80;
        float gl[8]; int gs = 0; float gm = -3.4e38f;
#pragma unroll
        for (int j = 0; j < 8; ++j) { gl[j] = rs * lg[j] + BI[j]; if (gl[j] > gm) { gm = gl[j]; gs = j; } }
        float den = 0.f;
#pragma unroll
        for (int j = 0; j < 8; ++j) den += __expf(gl[j] - gm);
        const float gw = 1.f / den;
        float v1 = -3.4e38f, v2 = -3.4e38f; int i1 = 0, i2 = 0;
#pragma unroll
        for (int e = 0; e < 8; ++e) { const float v = rs * lg[16 + 8 * gs + e] + BI[8 + 8 * gs + e];
            if (v > v1) { v2 = v1; i2 = i1; v1 = v; i1 = e; } else if (v > v2) { v2 = v; i2 = e; } }
        const float p1 = 1.f / (1.f + __expf(v2 - v1));
        int* re = (int*)(P.ws + WS_ROUTE + RT_E); float* rgt = (float*)(P.ws + WS_ROUTE + RT_G); float* rr = (float*)(P.ws + WS_ROUTE + RT_RSTD);
        re[2 * t] = 8 * gs + i1; re[2 * t + 1] = 8 * gs + i2; rgt[2 * t] = p1 * gw; rgt[2 * t + 1] = (1.f - p1) * gw; rr[t] = rs;
        atomicAdd((int*)(lds + RT_HS) + 8 * gs + i1, 1); atomicAdd((int*)(lds + RT_HS) + 8 * gs + i2, 1);
    }
    __syncthreads();
    if (tid < 64) ((int*)(P.ws + WS_ROUTE + RT_HIST))[rg * 64 + tid] = HS[tid];
    __syncthreads();
}

DI void lists_phase(const Params& P, LAS unsigned char* lds, int rgA, int rgB) {
    int tid_o = threadIdx.x; asm volatile("" : "+v"(tid_o)); const int tid = tid_o;
    LAS int* TOT = (LAS int*)lds; LAS int* PREA = TOT + 64; LAS int* PREB = TOT + 128; LAS int* PST = TOT + 192; LAS int* EA = TOT + 320; LAS int* PART = TOT + 1024;
    const int* hist = (const int*)(P.ws + WS_ROUTE + RT_HIST);
    const int* re = (const int*)(P.ws + WS_ROUTE + RT_E); const float* rgt = (const float*)(P.ws + WS_ROUTE + RT_G); const float* rr = (const float*)(P.ws + WS_ROUTE + RT_RSTD);
    int* stok = (int*)(P.ws + WS_ROUTE + RT_STOK); int* stk = (int*)(P.ws + WS_ROUTE + RT_STK); float* sg = (float*)(P.ws + WS_ROUTE + RT_SGATE); float* srs = (float*)(P.ws + WS_ROUTE + RT_SRSTD);
    int* texp = (int*)(P.ws + WS_ROUTE + RT_TEXP);
    { const int e = tid & 63, part = tid >> 6; int tot = 0, pa = 0, pb = 0;
#pragma unroll 8
        for (int q = 0; q < 64; ++q) { const int r = part * 64 + q; const int v = hist[r * 64 + e]; tot += v; pa += (r < rgA) ? v : 0; pb += (r < rgB) ? v : 0; }
        PART[part * 64 + e] = tot; PART[512 + part * 64 + e] = pa; PART[1024 + part * 64 + e] = pb; }
    __syncthreads();
    if (tid < 64) { int tot = 0, pa = 0, pb = 0;
#pragma unroll
        for (int p = 0; p < 8; ++p) { tot += PART[p * 64 + tid]; pa += PART[512 + p * 64 + tid]; pb += PART[1024 + p * 64 + tid]; }
        TOT[tid] = tot; PREA[tid] = pa; PREB[tid] = pb; }
    __syncthreads();
    if (tid == 0) { int s = 0; for (int e = 0; e < 64; ++e) { PST[e] = s; s += (TOT[e] + 255) & ~255; } PST[64] = s; }
    __syncthreads();
    for (int pass = 0; pass < 2; ++pass) {
        const int rg = pass ? rgB : rgA; const LAS int* PRE = pass ? PREB : PREA;
        if (rg >= 0) {
            if (tid < 256) EA[tid] = re[rg * 256 + tid];
            __syncthreads();
            if (tid < 256) { const int e = EA[tid]; int rank = 0; for (int a = 0; a < tid; ++a) rank += (EA[a] == e) ? 1 : 0;
                const int slot = PST[e] + PRE[e] + rank, t = rg * 128 + (tid >> 1), k = tid & 1;
                stok[slot] = t; stk[slot] = t | (k << 16); sg[slot] = rgt[rg * 256 + tid]; srs[slot] = rr[t]; ((int*)(P.ws + WS_ROUTE + RT_TSLOT))[2 * t + k] = slot; }
            __syncthreads();
        }
    }
    if (blockIdx.x < 64) { const int e = blockIdx.x; for (int s = PST[e] + TOT[e] + tid; s < PST[e + 1]; s += NTHREADS) { stok[s] = 0; stk[s] = -1; sg[s] = 0.f; srs[s] = 0.f; } }
    if (blockIdx.x == 64) { for (int t = tid; t < MAXTILES; t += NTHREADS) { int e = -1; for (int q = 0; q < 64; ++q) if (PST[q] <= 256 * t && 256 * t < PST[q + 1]) e = q; texp[t] = e; }
        if (tid == 0) texp[MAXTILES] = PST[64] >> 8; }
    __syncthreads();
}

DI void phase_final(const Params& P, bool with_moe) {
    int tid_o = threadIdx.x; asm volatile("" : "+v"(tid_o)); const int tid = tid_o, lane = tid & 63, wave = __builtin_amdgcn_readfirstlane(tid >> 6); const int gw = blockIdx.x * 8 + wave, NGW = gridDim.x * 8;
    const unsigned char* Y = P.ws + WS_Y; const float* g = P.in[22]; const int* tslot = (const int*)(P.ws + WS_ROUTE + RT_TSLOT);
    const bf16* hbase = (const bf16*)(P.ws + WS_PGLA);
    f32x4 gv[4];
#pragma unroll
    for (int j = 0; j < 4; ++j) gv[j] = ((const f32x4*)g)[lane + 64 * j];
    u32x2 hn[4]; int yan[4], ybn[4]; int s0n = 0, s1n = 0;
    int t = gw;
    if (t < TR) { const int s0 = with_moe ? tslot[2 * t] : 0, s1 = with_moe ? tslot[2 * t + 1] : 0;
        const u32x2* hh = (const u32x2*)H1HI(hbase, t) + lane; const int* ya = (const int*)(Y + (size_t)s0 * 1024) + lane; const int* yb = (const int*)(Y + (size_t)s1 * 1024) + lane;
#pragma unroll
        for (int j = 0; j < 4; ++j) { hn[j] = hh[64 * j]; yan[j] = ya[64 * j]; ybn[j] = yb[64 * j]; }
        if (t + NGW < TR && with_moe) { s0n = tslot[2 * (t + NGW)]; s1n = tslot[2 * (t + NGW) + 1]; } }
#pragma nounroll
    for (; t < TR; t += NGW) {
        u32x2 hc[4]; int yac[4], ybc[4];
#pragma unroll
        for (int j = 0; j < 4; ++j) { hc[j] = hn[j]; yac[j] = yan[j]; ybc[j] = ybn[j]; }
        const int tn = t + NGW;
        if (tn < TR) { const u32x2* hh = (const u32x2*)H1HI(hbase, tn) + lane; const int* ya = (const int*)(Y + (size_t)s0n * 1024) + lane; const int* yb = (const int*)(Y + (size_t)s1n * 1024) + lane;
#pragma unroll
            for (int j = 0; j < 4; ++j) { hn[j] = hh[64 * j]; yan[j] = ya[64 * j]; ybn[j] = yb[64 * j]; }
            if (tn + NGW < TR && with_moe) { s0n = tslot[2 * (tn + NGW)]; s1n = tslot[2 * (tn + NGW) + 1]; } }
        f32x4 v[4]; float s = 0.f;
#pragma unroll
        for (int j = 0; j < 4; ++j) { v[j] = (f32x4){bflo(hc[j].x), bfhi(hc[j].x), bflo(hc[j].y), bfhi(hc[j].y)};
            if (with_moe) { const int y0 = yac[j], y1 = ybc[j];
                v[j][0] += (__builtin_amdgcn_cvt_f32_fp8(y0, 0) + __builtin_amdgcn_cvt_f32_fp8(y1, 0)) * 0.125f; v[j][1] += (__builtin_amdgcn_cvt_f32_fp8(y0, 1) + __builtin_amdgcn_cvt_f32_fp8(y1, 1)) * 0.125f;
                v[j][2] += (__builtin_amdgcn_cvt_f32_fp8(y0, 2) + __builtin_amdgcn_cvt_f32_fp8(y1, 2)) * 0.125f; v[j][3] += (__builtin_amdgcn_cvt_f32_fp8(y0, 3) + __builtin_amdgcn_cvt_f32_fp8(y1, 3)) * 0.125f; }
            s += (v[j][0] * v[j][0] + v[j][1] * v[j][1]) + (v[j][2] * v[j][2] + v[j][3] * v[j][3]); }
        const float rs = rsqrtf(wave_sum(s) * (1.f / 1024.f) + EPS);
        f32x4* hr = (f32x4*)(P.out + (size_t)t * 1024) + lane;
#pragma unroll
        for (int j = 0; j < 4; ++j) hr[64 * j] = v[j] * rs * gv[j];
    }
}


#define XB_TMO      128
#define XB_XCNT(j)  (256  + 64 * (j))
#define XB_XSUB(j)  (1280 + 64 * (j))
#define XB_XGEN(j)  (2304 + 64 * (j))
#define XB_TOP      3328
#define XB_TOPGEN   3392
#define XCD_BAR_WORDS 3456
#define XB_SPIN_CAP (1u << 22)
DI unsigned xb_ld(unsigned* p)              { return __hip_atomic_load(p, __ATOMIC_RELAXED, __HIP_MEMORY_SCOPE_AGENT); }
DI unsigned xb_add(unsigned* p, unsigned v) { return __hip_atomic_fetch_add(p, v, __ATOMIC_RELAXED, __HIP_MEMORY_SCOPE_AGENT); }
DI unsigned xb_xcc_id() { return (unsigned)__builtin_amdgcn_s_getreg((3 << 11) | 20) & 0xFu; }
#define XB_SPIN(cond, bar) do { unsigned _sp = 0; while (cond) { __builtin_amdgcn_s_sleep(1); \
    if ((++_sp & 255u) == 0u) { if (xb_ld(&(bar)[XB_TMO])) break; if (_sp > XB_SPIN_CAP) { atomicAdd(&(bar)[XB_TMO], 1u); break; } } } } while (0)
struct XcdBarrier { unsigned* bar; unsigned x; volatile LAS unsigned* st; };
DI XcdBarrier xcd_barrier_post(unsigned* bar, volatile LAS unsigned* st) {
    XcdBarrier b; b.bar = bar; b.x = xb_xcc_id(); b.st = st;
    if (threadIdx.x == 0) (void)xb_add(&bar[XB_XCNT(b.x)], 1u);
    return b;
}
DI void xcd_barrier_complete(unsigned* bar, unsigned x, unsigned& nloc, unsigned& nx) {
    const unsigned G = gridDim.x * gridDim.y * gridDim.z;
    unsigned sum, cnt, mine, sp = 0u;
    for (;;) {
        sum = 0u; cnt = 0u; mine = 0u;
#pragma unroll
        for (unsigned j = 0; j < 16; ++j) { const unsigned c = xb_ld(&bar[XB_XCNT(j)]); sum += c; cnt += (c > 0u) ? 1u : 0u; mine = (j == x) ? c : mine; }
        if (sum == G) break;
        __builtin_amdgcn_s_sleep(1);
        if ((++sp & 255u) == 0u) { if (xb_ld(&bar[XB_TMO])) break; if (sp > XB_SPIN_CAP) { atomicAdd(&bar[XB_TMO], 1u); break; } }
    }
    nloc = mine > 0u ? mine : 1u; nx = cnt > 0u ? cnt : 1u;
}
DI void xcd_barrier(const XcdBarrier& b) {
    asm volatile("s_waitcnt vmcnt(0)" ::: "memory");
    __syncthreads();
    if (threadIdx.x == 0) {
        unsigned* bar = b.bar;
        __builtin_amdgcn_s_waitcnt(0);
        unsigned nloc = b.st[0], nx = b.st[1];
        if (nloc == 0u) { xcd_barrier_complete(bar, b.x, nloc, nx); b.st[0] = nloc; b.st[1] = nx; }
        const unsigned old = xb_add(&bar[XB_XSUB(b.x)], 1u);
        const unsigned gen = old / nloc;
        if (old + 1u == (gen + 1u) * nloc) {
            __builtin_amdgcn_fence(__ATOMIC_RELEASE, "agent");
            asm volatile("s_waitcnt vmcnt(0)" ::: "memory");
            const unsigned og = xb_add(&bar[XB_TOP], 1u);
            const unsigned tg = og / nx;
            if (og + 1u == (tg + 1u) * nx) xb_add(&bar[XB_TOPGEN], 1u);
            else XB_SPIN(xb_ld(&bar[XB_TOPGEN]) == tg, bar);
            __builtin_amdgcn_fence(__ATOMIC_ACQUIRE, "agent");
            xb_add(&bar[XB_XGEN(b.x)], 1u);
            asm volatile("s_waitcnt vmcnt(0)" ::: "memory");
        } else {
            XB_SPIN(xb_ld(&bar[XB_XGEN(b.x)]) == gen, bar);
            __builtin_amdgcn_fence(__ATOMIC_ACQUIRE, "agent");
            asm volatile("s_waitcnt vmcnt(0)" ::: "memory");
        }
    }
    __syncthreads();
}

#ifndef MOE_ENABLED
#define MOE_ENABLED 1
#endif
constexpr int NPH = 13;
__global__ void __launch_bounds__(NTHREADS, 2) mega(Params P) {
    extern __shared__ __attribute__((aligned(16))) unsigned char lds_raw[];
    LAS unsigned char* lds = (LAS unsigned char*)lds_raw;
    cg::grid_group grid = cg::this_grid();
    volatile LAS unsigned* MISC = (volatile LAS unsigned*)(lds + LDS_BYTES - 64);
    if (threadIdx.x < 16) MISC[threadIdx.x] = 0u;
    __syncthreads();
    const XcdBarrier xbar = xcd_barrier_post((unsigned*)(P.ws + WS_CTL + 65536), MISC);
    const int G = gridDim.x, c = blockIdx.x;
#define KWS (P.ws)
#define KXN ((bf16*)P.out)
#define KPDN ((bf16*)(P.ws + WS_PDN))
#define KPGLA ((bf16*)(P.ws + WS_PGLA))
#define RUN_0 { phase_p0(P, lds); }
#define RUN_1 { MapPlain mp{(const char*)KXN, (const char*)(KWS + WS_W1T), (size_t)256 * 1024 * 2, (size_t)256 * 1024 * 2}; DenseOrder<MapPlain> S; S.init(TP / 256, N1 / 256, G, c, mp); \
        EpiProj E{KPDN, KPGLA, (bf16*)(KWS + WS_HALO), (float*)(KWS + WS_SMALL)}; \
        pg8::gemm_phase<EpiProj, DenseOrder<MapPlain>, false>(lds, 1024, 1024, S, E); }
#define RUN_2 { __syncthreads(); prep_dn_phase(P, lds); __syncthreads(); prep_gla_phase(P, lds); }
#define RUN_3 { __syncthreads(); for (int it = c; it < BATCH * 8; it += G) scan_dn_item(P, lds, it); for (int it = c; it < BATCH * 8; it += G) scan_gla_item(P, lds, it); }
#define RUN_4 { __syncthreads(); \
        phase_px(P, lds, G == 256); __syncthreads(); \
        MapReal mp{(const char*)KXN, (const char*)(KWS + WS_WZR), (size_t)2048, (size_t)256 * 1024 * 2}; SplitOrder<MapReal> S; S.init(256, 8, G, c, mp, 6, 4); \
        EpiZR E{KPDN, KPGLA, (const float*)(KWS + WS_SSQ_DN), (const float*)(KWS + WS_SSQ_GLA), P.in[7], P.in[11], KWS + WS_OG8}; \
        pg8::gemm_phase<EpiZR, SplitOrder<MapReal>, false>(lds, 1024, 1024, S, E); }
#define RUN_5 { \
        { MapReal mp{(const char*)KPDN, (const char*)(KWS + WS_WPDN), (size_t)3072 * 2, (size_t)256 * 1024 * 2}; DenseOrder<MapReal> S; S.init(256, 4, G, c, mp); \
            EpiStoreReal E{KPDN + 1024, 3072, 1.f}; pg8::gemm_phase<EpiStoreReal, DenseOrder<MapReal>, false>(lds, 1024, 3072, S, E); } \
        { MapPlain mp{(const char*)(KWS + WS_OG8), (const char*)(KWS + WS_WPGLA), (size_t)256 * 1024, (size_t)256 * 1024}; DenseOrder<MapPlain> S; S.init(256, 4, G, c, mp); \
            EpiStoreReal E{KPDN + 2048, 3072, 1.f / 32.f}; pg8::gemm_phase<EpiStoreReal, DenseOrder<MapPlain>, false, true>(lds, 512, 512, S, E); } }
#define RUN_6 { MapReal mp{(const char*)P.out + XN8_OFF, (const char*)(KWS + WS_WG), (size_t)1024, (size_t)256 * 1024}; DenseOrder<MapReal> S; S.init(256, 8, G, c, mp); \
        EpiMerge E{KPDN + 1024, KPDN + 2048, KPGLA}; pg8::gemm_phase<EpiMerge, DenseOrder<MapReal>, false, true>(lds, 512, 512, S, E); }
#define RUN_7 { MapReal mp{(const char*)KPGLA, (const char*)(KWS + WS_WOUT), (size_t)2048 * 2, (size_t)256 * 1024 * 2}; DenseOrder<MapReal> S; S.init(256, 4, G, c, mp); \
        EpiOut E{P.in[0], (bf16*)P.out, (bf16*)(P.ws + WS_PGLA)}; pg8::gemm_phase<EpiOut, DenseOrder<MapReal>, false>(lds, 1024, 2048, S, E); }
#define RUN_8 { __syncthreads(); for (int rg = c; rg < 512; rg += G) router_group(P, lds, rg); }
#define RUN_9 { __syncthreads(); lists_phase(P, lds, c < 512 ? c : -1, c + G < 512 ? c + G : -1); }
#define RUN_10 { __syncthreads(); const int* texp = (const int*)(KWS + WS_ROUTE + RT_TEXP); \
        ExpertOrder S{texp[MAXTILES], G, c, texp, (const int*)(KWS + WS_ROUTE + RT_STOK), (const char*)(KWS + WS_XB), (const char*)(KWS + WS_WEXP13), (size_t)0, (size_t)1024 * 1024, (size_t)256 * 1024}; \
        EpiE1 E{(const float*)(KWS + WS_ROUTE + RT_SRSTD), KWS + WS_H}; pg8::gemm_phase<EpiE1, ExpertOrder, true, true>(lds, 512, 512, S, E); }
#define RUN_11 { const int* texp = (const int*)(KWS + WS_ROUTE + RT_TEXP); \
        ExpertOrder S{texp[MAXTILES], G, c, texp, (const int*)(KWS + WS_ROUTE + RT_STOK), (const char*)(KWS + WS_H), (const char*)(KWS + WS_WEXP2), (size_t)256 * 512, (size_t)1024 * 512, (size_t)256 * 512}; \
        EpiE2 E{(const float*)(KWS + WS_ROUTE + RT_SGATE), KWS + WS_Y}; pg8::gemm_phase<EpiE2, ExpertOrder, false, true>(lds, 256, 256, S, E); }
#define RUN_12 { phase_final(P, MOE_ENABLED != 0); }
#define SY xcd_barrier(xbar);
#define SY0 grid.sync();
#ifndef PROGRAM
#define PROGRAM RUN_0 SY0 RUN_1 SY RUN_2 SY RUN_3 SY RUN_4 SY RUN_5 SY RUN_6 SY RUN_7 SY RUN_8 SY RUN_9 SY RUN_10 SY RUN_11 SY RUN_12
#endif
    PROGRAM
}

extern "C" void kernel_launch(void* const* d_in, const int* in_sizes, int n_in, void* d_out, int out_size, void* d_ws, size_t ws_size, hipStream_t stream) {
    static int grid = 0;
    if (grid == 0) {
        if (n_in != 23 || out_size != TR * 1024 || ws_size < WS_END) { fprintf(stderr, "kernel_launch: unexpected problem (n_in %d out %d ws %zu)\n", n_in, out_size, ws_size); grid = -1; return; }
        if (hipFuncSetAttribute((const void*)mega, hipFuncAttributeMaxDynamicSharedMemorySize, LDS_BYTES) != hipSuccess) { fprintf(stderr, "kernel_launch: hipFuncSetAttribute failed\n"); grid = -1; return; }
        int dev = 0, cus = 0, per_cu = 0; (void)hipGetDevice(&dev); (void)hipDeviceGetAttribute(&cus, hipDeviceAttributeMultiprocessorCount, dev);
        (void)hipOccupancyMaxActiveBlocksPerMultiprocessor(&per_cu, (const void*)mega, NTHREADS, LDS_BYTES);
        (void)hipGetLastError();
        if (per_cu < 1) { fprintf(stderr, "kernel_launch: occupancy query says %d blocks/CU\n", per_cu); }
        grid = cus;
        if (grid != 256) fprintf(stderr, "kernel_launch: note: %d CUs\n", grid);
    }
    if (grid < 0) return;
    Params p; memset(&p, 0, sizeof(p));
    for (int i = 0; i < 23; ++i) p.in[i] = (const float*)d_in[i];
    p.out = (float*)d_out; p.ws = (unsigned char*)d_ws;
    if (hipMemsetAsync((char*)d_ws + WS_CTL, 0, 1 << 20, stream) != hipSuccess) { fprintf(stderr, "memset failed\n"); return; }
    void* args[] = {&p};
    hipError_t e = hipLaunchCooperativeKernel((const void*)mega, dim3(grid), dim3(NTHREADS), args, LDS_BYTES, stream);
    if (e != hipSuccess) fprintf(stderr, "cooperative launch failed: %s\n", hipGetErrorString(e));
}
```

```cpp
#include <hip/hip_runtime.h>
#include <hip/hip_cooperative_groups.h>
#include <cstdio>
#include <cstdint>
#include <cstring>
namespace cg = cooperative_groups;

#define DI __device__ __forceinline__
#define LAS __attribute__((address_space(3)))
typedef unsigned short bf16;
typedef short bf16x8 __attribute__((ext_vector_type(8)));
typedef float f32x4 __attribute__((ext_vector_type(4)));
typedef float f32x16 __attribute__((ext_vector_type(16)));
typedef unsigned u32x4 __attribute__((ext_vector_type(4)));
typedef unsigned u32x2 __attribute__((ext_vector_type(2)));
typedef __bf16 bf16x2_t __attribute__((ext_vector_type(2)));
typedef float f32x2_t __attribute__((ext_vector_type(2)));

constexpr int DM = 1024, BATCH = 32, SEQ = 2048, NMETA = 16, LP = 2112, NCH = 33;
constexpr int TP = BATCH * LP;
constexpr int TR = BATCH * SEQ;
constexpr int N1 = 5376;
constexpr int NGCH = BATCH * NCH;
constexpr int NIT_DN = NGCH * 8, NIT_GLA = NGCH * 4;
constexpr int MAXTILES = 576, MAXSLOTS = MAXTILES * 256;
constexpr float EPS = 1e-6f;
constexpr int NTHREADS = 512;
constexpr int LDS_BYTES = 163840;

constexpr size_t MiB = 1u << 20;
constexpr size_t XN8_OFF = 144 * MiB;
#define H1HI(base_, t_) ((base_) + ((size_t)((t_) >> 11) * LP + 64 + ((t_) & 2047)) * 2048 + 1024)
constexpr size_t WS_CTL = 0;
#define WS_OG8 (WS_EXT + 64 * MiB)
constexpr size_t WS_W1T = 1 * MiB;
constexpr size_t WS_WZR = 12 * MiB;
constexpr size_t WS_WG = 16 * MiB;
constexpr size_t WS_WPDN = 20 * MiB, WS_WPGLA = 22 * MiB, WS_WOUT = 24 * MiB;
constexpr size_t WS_WRT = 26 * MiB;
constexpr size_t WS_SMALL = 27 * MiB;
constexpr size_t WS_HALO = 36 * MiB;
constexpr size_t WS_SSQ_DN = 55 * MiB;
constexpr size_t WS_SSQ_GLA = 58 * MiB;
constexpr size_t WS_SC_DN = 61 * MiB;
constexpr size_t WS_EBL = 64 * MiB;
constexpr size_t WS_ROUTE = 67 * MiB;
constexpr size_t WS_PDN = 72 * MiB;
constexpr size_t WS_PGLA = 468 * MiB;
constexpr size_t WS_EXT = 732 * MiB;
constexpr size_t WS_ATT = 930 * MiB;
constexpr size_t WS_END = 963 * MiB;
constexpr size_t WS_WEXP13 = WS_EXT;
constexpr size_t WS_WEXP2 = WS_EXT + 128 * MiB;
constexpr size_t WS_XB = WS_PDN;
constexpr size_t WS_H = WS_PDN + 128 * MiB;
constexpr size_t WS_Y = WS_PDN + 252 * MiB;
static_assert(WS_Y + (size_t)MAXSLOTS * 1024 <= WS_PGLA && WS_H + (size_t)MAXSLOTS * 512 <= WS_Y, "MoE overlays");
constexpr size_t RT_E = 0;
constexpr size_t RT_G = 512 * 1024;
constexpr size_t RT_RSTD = 1024 * 1024;
constexpr size_t RT_HIST = 1280 * 1024;
constexpr size_t RT_STOK = 1536 * 1024;
constexpr size_t RT_STK = 2176 * 1024;
constexpr size_t RT_SGATE = 2816 * 1024;
constexpr size_t RT_SRSTD = 3456 * 1024;
constexpr size_t RT_TEXP = 4096 * 1024;
constexpr size_t RT_TSLOT = 4200 * 1024;
static_assert(RT_TSLOT + (size_t)TR * 8 <= 5 * MiB && RT_TEXP + (MAXTILES + 1) * 4 <= RT_TSLOT, "route map");
static_assert(WS_EXT + (size_t)NIT_DN * 24576 <= WS_ATT && WS_ATT + (size_t)NIT_GLA * 8192 <= WS_END, "ws map");
static_assert(WS_PDN + (size_t)TP * 3072 * 2 <= WS_PGLA && WS_PGLA + (size_t)TP * 2048 * 2 <= WS_EXT, "ws map 2");

DI unsigned pk2(float lo, float hi) { f32x2_t v = {lo, hi}; bf16x2_t b = __builtin_convertvector(v, bf16x2_t); return __builtin_bit_cast(unsigned, b); }
DI float bflo(unsigned u) { return __uint_as_float(u << 16); }
DI float bfhi(unsigned u) { return __uint_as_float(u & 0xffff0000u); }
DI float bf2f(bf16 b) { return __uint_as_float(((unsigned)b) << 16); }
DI bf16 f2bf(float f) { return (bf16)(pk2(f, 0.f) & 0xffffu); }
typedef int v8i_t __attribute__((ext_vector_type(8)));
typedef int v4i_t __attribute__((ext_vector_type(4)));
DI unsigned pk4_fp8(float a, float b, float c, float d) { int w = 0; w = __builtin_amdgcn_cvt_pk_fp8_f32(a, b, w, false); w = __builtin_amdgcn_cvt_pk_fp8_f32(c, d, w, true); return (unsigned)w; }
DI float sigmoidf_(float x) { return __builtin_amdgcn_rcpf(1.f + __expf(-x)); }
DI float siluf_(float x) { return x * __builtin_amdgcn_rcpf(1.f + __expf(-x)); }
DI float softplusf_(float x) { return x > 20.f ? x : log1pf(__expf(x)); }
DI float logsigmoidf_(float x) { return fminf(x, 0.f) - __logf(1.f + __expf(-fabsf(x))); }
DI float wave_sum(float v) {
#pragma unroll
    for (int o = 1; o < 64; o <<= 1) v += __shfl_xor(v, o);
    return v;
}
#define LDS_WAIT() asm volatile("s_waitcnt lgkmcnt(0)" ::: "memory")
DI int rowmap(int pm) { return (pm >> 3) * LP + 64 + (pm & 7) * 256; }
DI int tok2row(int t) { return (t >> 11) * LP + 64 + (t & 2047); }

struct Params { const float* in[23]; float* out; unsigned char* ws; };

namespace pg8 {
constexpr int BM = 256, BK = 64, HALF = 128, HTB = HALF * BK * 2, STAGE_BYTES = 8 * HTB;
DI int lds_byte(int r, int c) { const int st = (r >> 4) * 2 + (c >> 5), rr = r & 15, cc = c & 31, ob = rr * 64 + cc * 2; return st * 1024 + (ob ^ (((ob >> 9) & 1) << 5)); }
DI void stage_rc(int b, int& R, int& C) { const int st = b / 1024, sb = b % 1024, swz = sb ^ (((sb >> 9) & 1) << 5); R = (st >> 1) * 16 + swz / 64; C = (st & 1) * 32 + (swz % 64) / 2; }
DI int perm32(int rho) { const int n = rho >> 4, i = rho & 15; return 8 * (i >> 2) + 4 * n + (i & 3); }
struct Unit { const char* a; const char* b; const int* gidx; int pm, pn, aux; };
typedef f32x4 Acc[2][2][4][2];

template <class Epi, class Sched, bool GATHER, bool FP8 = false>
DI void gemm_phase(LAS unsigned char* lds, const int K, const int lda, const Sched& S, const Epi& E) {
    int tid_ = threadIdx.x; asm volatile("" : "+v"(tid_));
    const int tid = tid_, wid = __builtin_amdgcn_readfirstlane(tid >> 6), lane = tid & 63, wr = wid >> 2, wc = wid & 3, fr = lane & 15, fq = lane >> 4;
    int nt_ = K / BK; asm volatile("" : "+s"(nt_)); const int nt = nt_;
    unsigned vA[2][2], nA[2][2], voffB[2]; int Rs[2], Cs[2];
#pragma unroll
    for (int i = 0; i < 2; ++i) { int R, C; stage_rc(tid * 16 + i * 8192, R, C); Rs[i] = R; Cs[i] = C; const int Rb = (R & ~31) + perm32(R & 31);
        voffB[i] = (unsigned)(Rb * K + C) * 2u;
        vA[0][i] = (unsigned)(R * lda + C) * 2u; vA[1][i] = (unsigned)((R + HALF) * lda + C) * 2u; nA[0][i] = vA[0][i]; nA[1][i] = vA[1][i]; }
    const size_t kstep = (size_t)(BK * 2);
    const size_t hstepB = (size_t)HALF * K * 2;
    const unsigned ldsw = (unsigned)wid * 1024u;
    const int aoff = lds_byte(wr * 64 + fr, fq * 8), boff = lds_byte(wc * 32 + fr, fq * 8);
#define PG8_SA(b, h) (((b) * 2 + (h)) * HTB)
#define PG8_SB(b, h) ((4 + (b) * 2 + (h)) * HTB)
#define PG8_STAGEB(bufoff, gbase) do { _Pragma("unroll") for (int _i = 0; _i < 2; ++_i) \
        __builtin_amdgcn_global_load_lds((const unsigned*)((const char*)(gbase) + voffB[_i]), (LAS unsigned*)(lds + (bufoff) + ldsw + _i * 8192), 16, 0, 0); } while (0)
#define PG8_STAGEA(bufoff, gbase, v0, v1) do { \
        __builtin_amdgcn_global_load_lds((const unsigned*)((const char*)(gbase) + (v0)), (LAS unsigned*)(lds + (bufoff) + ldsw), 16, 0, 0); \
        __builtin_amdgcn_global_load_lds((const unsigned*)((const char*)(gbase) + (v1)), (LAS unsigned*)(lds + (bufoff) + ldsw + 8192), 16, 0, 0); } while (0)
#define PG8_LDA(dst, b, h) do { if constexpr (FP8) { _Pragma("unroll") for (int m = 0; m < 4; ++m) { const v4i_t lo_ = *(const LAS v4i_t*)(lds + PG8_SA(b, h) + aoff + m * 2048), hi_ = *(const LAS v4i_t*)(lds + PG8_SA(b, h) + aoff + m * 2048 + 1024); \
            dst##8[m] = __builtin_shufflevector(lo_, hi_, 0, 1, 2, 3, 4, 5, 6, 7); } } \
        else { _Pragma("unroll") for (int m = 0; m < 4; ++m) _Pragma("unroll") for (int k = 0; k < 2; ++k) dst[m][k] = *(const LAS bf16x8*)(lds + PG8_SA(b, h) + aoff + m * 2048 + k * 1024); } } while (0)
#define PG8_LDB(dst, b, h) do { if constexpr (FP8) { _Pragma("unroll") for (int n = 0; n < 2; ++n) { const v4i_t lo_ = *(const LAS v4i_t*)(lds + PG8_SB(b, h) + boff + n * 2048), hi_ = *(const LAS v4i_t*)(lds + PG8_SB(b, h) + boff + n * 2048 + 1024); \
            dst##8[n] = __builtin_shufflevector(lo_, hi_, 0, 1, 2, 3, 4, 5, 6, 7); } } \
        else { _Pragma("unroll") for (int n = 0; n < 2; ++n) _Pragma("unroll") for (int k = 0; k < 2; ++k) dst[n][k] = *(const LAS bf16x8*)(lds + PG8_SB(b, h) + boff + n * 2048 + k * 1024); } } while (0)
#define PG8_MMA(ai, bj, At, Bt) do { __builtin_amdgcn_s_setprio(1); \
        if constexpr (FP8) {   \
            asm volatile("s_nop 4\n\t" \
                "v_mfma_scale_f32_16x16x128_f8f6f4 %0, %8, %10, %0, %14, %14 op_sel_hi:[0,0,0]\n\t" "v_mfma_scale_f32_16x16x128_f8f6f4 %1, %9, %10, %1, %14, %14 op_sel_hi:[0,0,0]\n\t" \
                "v_mfma_scale_f32_16x16x128_f8f6f4 %2, %8, %11, %2, %14, %14 op_sel_hi:[0,0,0]\n\t" "v_mfma_scale_f32_16x16x128_f8f6f4 %3, %9, %11, %3, %14, %14 op_sel_hi:[0,0,0]\n\t" \
                "v_mfma_scale_f32_16x16x128_f8f6f4 %4, %8, %12, %4, %14, %14 op_sel_hi:[0,0,0]\n\t" "v_mfma_scale_f32_16x16x128_f8f6f4 %5, %9, %12, %5, %14, %14 op_sel_hi:[0,0,0]\n\t" \
                "v_mfma_scale_f32_16x16x128_f8f6f4 %6, %8, %13, %6, %14, %14 op_sel_hi:[0,0,0]\n\t" "v_mfma_scale_f32_16x16x128_f8f6f4 %7, %9, %13, %7, %14, %14 op_sel_hi:[0,0,0]" \
                : "+v"(acc[ai][bj][0][0]), "+v"(acc[ai][bj][0][1]), "+v"(acc[ai][bj][1][0]), "+v"(acc[ai][bj][1][1]), "+v"(acc[ai][bj][2][0]), "+v"(acc[ai][bj][2][1]), "+v"(acc[ai][bj][3][0]), "+v"(acc[ai][bj][3][1]) \
                : "v"(Bt##8[0]), "v"(Bt##8[1]), "v"(At##8[0]), "v"(At##8[1]), "v"(At##8[2]), "v"(At##8[3]), "v"(one_scale)); } \
        else { _Pragma("unroll") for (int m = 0; m < 4; ++m) _Pragma("unroll") for (int n = 0; n < 2; ++n) _Pragma("unroll") for (int k = 0; k < 2; ++k) \
            acc[ai][bj][m][n] = __builtin_amdgcn_mfma_f32_16x16x32_bf16(Bt[n][k], At[m][k], acc[ai][bj][m][n], 0, 0, 0); } \
        __builtin_amdgcn_s_setprio(0); } while (0)
#define PG8_WAIT_V(n) asm volatile("s_waitcnt vmcnt(" #n ")" ::: "memory")
#define PG8_WAIT_L(n) asm volatile("s_waitcnt lgkmcnt(" #n ")" ::: "memory")
#define PG8_BAR __builtin_amdgcn_s_barrier()
#define PG8_SCHED __builtin_amdgcn_sched_barrier(0)
#define PG8_GIDX(dst, u) do { if constexpr (GATHER) { _Pragma("unroll") for (int _h = 0; _h < 2; ++_h) _Pragma("unroll") for (int _i = 0; _i < 2; ++_i) \
        dst[_h][_i] = (unsigned)((u).gidx[Rs[_i] + _h * HALF]) * (unsigned)(lda * 2) + (unsigned)(Cs[_i] * 2); } } while (0)
    Unit cur, nxt; int ui = 0;
    if (!S.next(0, cur)) return;
    Acc acc;
#pragma unroll
    for (int a = 0; a < 2; ++a)
#pragma unroll
        for (int b = 0; b < 2; ++b)
#pragma unroll
            for (int m = 0; m < 4; ++m)
#pragma unroll
                for (int n = 0; n < 2; ++n) acc[a][b][m][n] = (f32x4){0.f, 0.f, 0.f, 0.f};
    int one_scale = 0x7f7f7f7f; asm volatile("" : "+v"(one_scale));
    bf16x8 At[4][2], B0[2][2], B1[2][2];
    v8i_t At8[4], B08[2], B18[2];
    const char* cA = cur.a; const char* cB = cur.b;
    PG8_GIDX(vA, cur);
    PG8_STAGEB(PG8_SB(0, 0), cB); PG8_STAGEB(PG8_SB(0, 1), cB + hstepB); PG8_STAGEA(PG8_SA(0, 0), cA, vA[0][0], vA[0][1]); PG8_STAGEA(PG8_SA(0, 1), cA, vA[1][0], vA[1][1]);
    if (wr == 1) PG8_BAR;
    PG8_WAIT_V(2); PG8_BAR;
    PG8_STAGEB(PG8_SB(1, 0), cB + kstep); PG8_STAGEA(PG8_SA(1, 0), cA + kstep, vA[0][0], vA[0][1]); PG8_STAGEB(PG8_SB(1, 1), cB + hstepB + kstep);
    PG8_WAIT_V(6); PG8_BAR;
    for (;;) {
        const bool has_next = S.next(ui + 1, nxt);
        const char* nAp = has_next ? nxt.a : cA; const char* nBp = has_next ? nxt.b : cB;
        for (int t = 0; t < nt; t += 2) {
            const bool last = (t == nt - 2);
            const char* a1 = cA + (size_t)(t + 1) * kstep;
            const char* a2 = last ? nAp : cA + (size_t)(t + 2) * kstep; const char* b2 = last ? nBp : cB + (size_t)(t + 2) * kstep;
            const char* a3 = a2 + kstep; const char* b3 = b2 + kstep;
            unsigned x00 = vA[0][0], x01 = vA[0][1], x10 = vA[1][0], x11 = vA[1][1];
            if constexpr (GATHER) { if (last && has_next) { PG8_GIDX(nA, nxt); x00 = nA[0][0]; x01 = nA[0][1]; x10 = nA[1][0]; x11 = nA[1][1]; } }
            PG8_LDB(B0, 0, 0); PG8_LDB(B1, 0, 1); PG8_SCHED; PG8_LDA(At, 0, 0); PG8_STAGEA(PG8_SA(1, 1), a1, vA[1][0], vA[1][1]);
            PG8_WAIT_V(8); PG8_WAIT_L(0); PG8_BAR; PG8_MMA(0, 0, At, B0); PG8_MMA(0, 1, At, B1); PG8_BAR; PG8_SCHED;
            PG8_LDA(At, 0, 1); PG8_STAGEB(PG8_SB(0, 0), b2); PG8_STAGEB(PG8_SB(0, 1), b2 + hstepB); PG8_STAGEA(PG8_SA(0, 0), a2, x00, x01);
            PG8_WAIT_V(8); PG8_WAIT_L(0); PG8_BAR; PG8_MMA(1, 0, At, B0); PG8_MMA(1, 1, At, B1); PG8_BAR; PG8_SCHED;
            PG8_LDB(B0, 1, 0); PG8_LDB(B1, 1, 1); PG8_SCHED; PG8_LDA(At, 1, 0); PG8_STAGEA(PG8_SA(0, 1), a2, x10, x11);
            PG8_WAIT_V(8); PG8_WAIT_L(0); PG8_BAR; PG8_MMA(0, 0, At, B0); PG8_MMA(0, 1, At, B1); PG8_BAR; PG8_SCHED;
            PG8_LDA(At, 1, 1); PG8_STAGEB(PG8_SB(1, 0), b3); PG8_STAGEB(PG8_SB(1, 1), b3 + hstepB); PG8_STAGEA(PG8_SA(1, 0), a3, x00, x01);
            PG8_WAIT_V(8); PG8_WAIT_L(0); PG8_BAR; PG8_MMA(1, 0, At, B0); PG8_MMA(1, 1, At, B1); PG8_BAR; PG8_SCHED;
        }
        if (wr == 0) PG8_BAR;
        if constexpr (FP8) asm volatile("s_nop 15\n\ts_nop 15" ::: "memory");
        E(acc, cur, wr, wc, fr, fq);
        if (!has_next) break;
#pragma unroll
        for (int a = 0; a < 2; ++a)
#pragma unroll
            for (int b = 0; b < 2; ++b)
#pragma unroll
                for (int m = 0; m < 4; ++m)
#pragma unroll
                    for (int n = 0; n < 2; ++n) acc[a][b][m][n] = (f32x4){0.f, 0.f, 0.f, 0.f};
        cur = nxt; cA = nAp; cB = nBp; ++ui;
        if constexpr (GATHER) {
#pragma unroll
            for (int h = 0; h < 2; ++h)
#pragma unroll
                for (int i = 0; i < 2; ++i) vA[h][i] = nA[h][i]; }
        if (wr == 1) PG8_BAR;
    }
    PG8_WAIT_V(0);
    PG8_BAR;
#undef PG8_SA
#undef PG8_SB
#undef PG8_STAGEA
#undef PG8_STAGEB
#undef PG8_LDA
#undef PG8_LDB
#undef PG8_MMA
#undef PG8_WAIT_V
#undef PG8_WAIT_L
#undef PG8_BAR
#undef PG8_SCHED
#undef PG8_GIDX
}
}

template <class Map> struct DenseOrder {
    int nM, nN, nwg, G, c; Map map;
    DI void init(int nM_, int nN_, int G_, int c_, const Map& m) { nM = nM_; nN = nN_; nwg = nM * nN; G = G_; c = c_; map = m; }
    DI bool next(int i, pg8::Unit& u) const { return next_L((long)i * G + c, u); }
    DI bool next_L(const long L, pg8::Unit& u) const {
        if (L >= nwg) return false;
        int wgid = (int)L; { const int q = nwg / 8, r = nwg % 8, xcd = wgid % 8, off = wgid / 8; wgid = (xcd < r ? xcd * (q + 1) : r * (q + 1) + (xcd - r) * q) + off; }
        const int nig = 8 * nN, gid = wgid / nig, fm = gid * 8, gsz = (nM - fm) < 8 ? (nM - fm) : 8;
        u.pm = fm + ((wgid % nig) % gsz); u.pn = (wgid % nig) / gsz; u.gidx = nullptr; u.aux = 0;
        map(u); return true;
    }
};
template <class Map> struct SplitOrder {
    DenseOrder<Map> D; int NL, EX, G, c; bool on;
    DI void init(int nM_, int nN_, int G_, int c_, const Map& m, int NL_, int EX_) { NL = NL_; EX = EX_; G = G_; c = c_; on = (G_ == 256) && (NL_ * 256 + EX_ * 128 == nM_ * nN_); D.init(nM_, nN_, G_, on ? 0 : c_, m); }
    DI bool next(int i, pg8::Unit& u) const {
        if (!on) return D.next(i, u);
        const bool light = ((c >> 3) & 1) == 0;
        long L;
        if (i < NL) L = (long)i * 256 + c;
        else { if (light || i >= NL + EX) return false; const int d = (c & 7) | ((c >> 4) << 3); L = (long)NL * 256 + (long)(i - NL) * 128 + d; }
        return D.next_L(L, u);
    }
};
struct MapPlain { const char* A; const char* B; size_t astride, bstride;
    DI void operator()(pg8::Unit& u) const { u.a = A + (size_t)u.pm * astride; u.b = B + (size_t)u.pn * bstride; } };
struct MapReal { const char* A; const char* B; size_t arow, bstride;
    DI void operator()(pg8::Unit& u) const { u.a = A + (size_t)rowmap(u.pm) * arow; u.b = B + (size_t)u.pn * bstride; } };
struct ExpertOrder {
    int ntiles, G, c; const int* texp; const int* stok; const char* A; const char* B; size_t atile, bexp, btile;
    DI bool next(int i, pg8::Unit& u) const {
        const long L = (long)i * G + c; if (L >= (long)ntiles * 4) return false;
        const int tile = (int)(L >> 2), pn = (int)(L & 3);
        int e; { const int off_ = __builtin_amdgcn_readfirstlane(tile << 2); asm volatile("s_load_dword %0, %1, %2\n\ts_waitcnt lgkmcnt(0)" : "=s"(e) : "s"(texp), "s"(off_) : "memory"); }
        u.pm = tile; u.pn = pn; u.aux = e; u.gidx = stok + tile * 256; u.a = A + (size_t)tile * atile; u.b = B + (size_t)e * bexp + (size_t)pn * btile; return true;
    }
};

#define EPI_LOOP_ROWS for (int ai = 0; ai < 2; ++ai) _Pragma("unroll") for (int m = 0; m < 4; ++m)
DI u32x4 pack8(const f32x4& v0, const f32x4& v1) { u32x4 w; w.x = pk2(v0[0], v0[1]); w.y = pk2(v0[2], v0[3]); w.z = pk2(v1[0], v1[1]); w.w = pk2(v1[2], v1[3]); return w; }
DI void unpack8(const u32x4 w, float* f) { f[0] = bflo(w.x); f[1] = bfhi(w.x); f[2] = bflo(w.y); f[3] = bfhi(w.y); f[4] = bflo(w.z); f[5] = bfhi(w.z); f[6] = bflo(w.w); f[7] = bfhi(w.w); }

struct EpiProj {
    bf16* pdn; bf16* pgla; bf16* halo; float* small;
    DI void operator()(const pg8::Acc& acc, const pg8::Unit& u, int wr, int wc, int fr, int fq) const {
        const int row0 = u.pm * 256 + wr * 64 + fr, cl = wc * 32 + 8 * fq;
        if (u.pn < 12) {
#pragma unroll
            EPI_LOOP_ROWS { const int R = row0 + ai * 128 + m * 16;
#pragma unroll
                for (int bj = 0; bj < 2; ++bj) { const int col = u.pn * 256 + bj * 128 + cl; const u32x4 w = pack8(acc[ai][bj][m][0], acc[ai][bj][m][1]);
                    *(u32x4*)(pdn + (size_t)R * 3072 + col) = w;
                    if ((R & 63) >= 61) *(u32x4*)(halo + ((size_t)(R >> 6) * 3 + ((R & 63) - 61)) * 3072 + col) = w; } }
        } else if (u.pn < 20) {
#pragma unroll
            EPI_LOOP_ROWS { const int R = row0 + ai * 128 + m * 16;
#pragma unroll
                for (int bj = 0; bj < 2; ++bj) { const int col = (u.pn - 12) * 256 + bj * 128 + cl;
                    *(u32x4*)(pgla + (size_t)R * 2048 + col) = pack8(acc[ai][bj][m][0], acc[ai][bj][m][1]); } }
        } else if (wc == 0) {
#pragma unroll
            EPI_LOOP_ROWS { const int R = row0 + ai * 128 + m * 16; float* p = small + (size_t)R * 32 + 8 * fq;
                *(f32x4*)p = acc[ai][0][m][0]; *(f32x4*)(p + 4) = acc[ai][0][m][1]; }
        }
    }
};
struct EpiZR {
    bf16* pdn; bf16* pgla; const float* ssq_dn; const float* ssq_gla; const float* nw_dn; const float* nw_gla; unsigned char* og8;
    DI void operator()(const pg8::Acc& acc, const pg8::Unit& u, int wr, int wc, int fr, int fq) const {
        const int R0 = rowmap(u.pm) + wr * 64 + fr, cl = wc * 32 + 8 * fq;
        const bool dn = u.pn < 4; const int hd = u.pn - 4;
        f32x4 nw[2][2];
#pragma unroll
        for (int bj = 0; bj < 2; ++bj) { const float* p = dn ? nw_dn + cl : nw_gla + bj * 128 + cl; nw[bj][0] = *(const f32x4*)p; nw[bj][1] = *(const f32x4*)(p + 4); }
#pragma unroll
        for (int am = 0; am < 4; ++am) { const int ai = am >> 1, mb = (am & 1) * 2;
            u32x4 ov[2][2]; float sa[2][2], sb[2][2];
#pragma unroll
            for (int mm = 0; mm < 2; ++mm) { const int R = R0 + ai * 128 + (mb + mm) * 16;
#pragma unroll
                for (int bj = 0; bj < 2; ++bj) {
                    const bf16* op = dn ? pdn + (size_t)R * 3072 + u.pn * 256 + bj * 128 + cl : pgla + (size_t)R * 2048 + 1024 + hd * 256 + bj * 128 + cl;
                    const float* sp = dn ? ssq_dn + (size_t)R * 8 + u.pn * 2 + bj : ssq_gla + (size_t)R * 8 + hd * 2;
                    ov[mm][bj] = *(const u32x4*)op; sa[mm][bj] = sp[0]; sb[mm][bj] = sp[dn ? 0 : 1]; } }
            __builtin_amdgcn_sched_barrier(0);
#pragma unroll
            for (int mm = 0; mm < 2; ++mm) { const int m = mb + mm; const int R = R0 + ai * 128 + m * 16;
#pragma unroll
                for (int bj = 0; bj < 2; ++bj) {
                    bf16* op = dn ? pdn + (size_t)R * 3072 + u.pn * 256 + bj * 128 + cl : pgla + (size_t)R * 2048 + 1024 + hd * 256 + bj * 128 + cl;
                    const float rs = rsqrtf(dn ? sa[mm][bj] * (1.f / 128.f) + EPS : (sa[mm][bj] + sb[mm][bj]) * (1.f / 256.f) + EPS);
                    float o[8]; unpack8(ov[mm][bj], o); f32x4 r0, r1;
#pragma unroll
                    for (int j = 0; j < 4; ++j) { r0[j] = o[j] * rs * nw[bj][0][j] * siluf_(acc[ai][bj][m][0][j]); r1[j] = o[4 + j] * rs * nw[bj][1][j] * siluf_(acc[ai][bj][m][1][j]); }
                    if (dn) *(u32x4*)op = pack8(r0, r1);
                    else { u32x2 w8; w8.x = pk4_fp8(r0[0], r0[1], r0[2], r0[3]); w8.y = pk4_fp8(r1[0], r1[1], r1[2], r1[3]);
                        *(u32x2*)(og8 + (size_t)(u.pm * 256 + wr * 64 + fr + ai * 128 + m * 16) * 1024 + hd * 256 + bj * 128 + cl) = w8; } } }
        }
    }
};
struct EpiStoreReal {
    bf16* dst; int ld; float scale;
    DI void operator()(const pg8::Acc& acc, const pg8::Unit& u, int wr, int wc, int fr, int fq) const {
        const int R0 = rowmap(u.pm) + wr * 64 + fr, cl = u.pn * 256 + wc * 32 + 8 * fq;
#pragma unroll
        EPI_LOOP_ROWS { const int R = R0 + ai * 128 + m * 16;
#pragma unroll
            for (int bj = 0; bj < 2; ++bj) *(u32x4*)(dst + (size_t)R * ld + cl + bj * 128) = pack8(acc[ai][bj][m][0] * scale, acc[ai][bj][m][1] * scale); }
    }
};
struct EpiStoreReal8 {
    unsigned char* dst; int ldb; float scale;
    DI void operator()(const pg8::Acc& acc, const pg8::Unit& u, int wr, int wc, int fr, int fq) const {
        const int R0 = rowmap(u.pm) + wr * 64 + fr, cl = u.pn * 256 + wc * 32 + 8 * fq;
#pragma unroll
        EPI_LOOP_ROWS { const int R = R0 + ai * 128 + m * 16;
#pragma unroll
            for (int bj = 0; bj < 2; ++bj) { const f32x4 v0 = acc[ai][bj][m][0] * scale, v1 = acc[ai][bj][m][1] * scale; u32x2 w; w.x = pk4_fp8(v0[0], v0[1], v0[2], v0[3]); w.y = pk4_fp8(v1[0], v1[1], v1[2], v1[3]);
                *(u32x2*)(dst + (size_t)R * ldb + cl + bj * 128) = w; } }
    }
};
struct EpiMerge {
    const bf16* ydn; const unsigned char* ygla8; bf16* merged;
    DI void operator()(const pg8::Acc& acc, const pg8::Unit& u, int wr, int wc, int fr, int fq) const {
        const int R0 = rowmap(u.pm) + wr * 64 + fr, col = u.pn * 128 + wc * 32 + 8 * fq;
        u32x4 ya[2][4]; u32x2 yb[2][4];
#pragma unroll
        for (int ai = 0; ai < 2; ++ai)
#pragma unroll
            for (int m = 0; m < 4; ++m) { const int R = R0 + ai * 128 + m * 16; ya[ai][m] = *(const u32x4*)(ydn + (size_t)R * 3072 + col); yb[ai][m] = *(const u32x2*)(ygla8 + (size_t)R * 6144 + col); }
        __builtin_amdgcn_sched_barrier(0);
#pragma unroll
        EPI_LOOP_ROWS { const int R = R0 + ai * 128 + m * 16;
            float a[8], b[8]; unpack8(ya[ai][m], a);
            { const int y0 = (int)yb[ai][m].x, y1 = (int)yb[ai][m].y;
                b[0] = __builtin_amdgcn_cvt_f32_fp8(y0, 0) * 0.125f; b[1] = __builtin_amdgcn_cvt_f32_fp8(y0, 1) * 0.125f; b[2] = __builtin_amdgcn_cvt_f32_fp8(y0, 2) * 0.125f; b[3] = __builtin_amdgcn_cvt_f32_fp8(y0, 3) * 0.125f;
                b[4] = __builtin_amdgcn_cvt_f32_fp8(y1, 0) * 0.125f; b[5] = __builtin_amdgcn_cvt_f32_fp8(y1, 1) * 0.125f; b[6] = __builtin_amdgcn_cvt_f32_fp8(y1, 2) * 0.125f; b[7] = __builtin_amdgcn_cvt_f32_fp8(y1, 3) * 0.125f; }
            f32x4 r0, r1;
#pragma unroll
            for (int j = 0; j < 4; ++j) { r0[j] = sigmoidf_(acc[ai][0][m][0][j] * (1.f / 32.f)) * a[j] + sigmoidf_(acc[ai][1][m][0][j] * (1.f / 32.f)) * b[j];
                r1[j] = sigmoidf_(acc[ai][0][m][1][j] * (1.f / 32.f)) * a[4 + j] + sigmoidf_(acc[ai][1][m][1][j] * (1.f / 32.f)) * b[4 + j]; }
            *(u32x4*)(merged + (size_t)R * 2048 + col) = pack8(r0, r1); }
    }
};
struct EpiOut {
    const float* x; bf16* hlo; bf16* hhi;
    DI void operator()(const pg8::Acc& acc, const pg8::Unit& u, int wr, int wc, int fr, int fq) const {
        const int t0 = u.pm * 256 + wr * 64 + fr, cl = u.pn * 256 + wc * 32 + 8 * fq;
#pragma unroll
        for (int ai = 0; ai < 2; ++ai)
#pragma unroll
            for (int mp = 0; mp < 2; ++mp) {
                f32x4 xv[2][2][2];
#pragma unroll
                for (int m2 = 0; m2 < 2; ++m2)
#pragma unroll
                    for (int bj = 0; bj < 2; ++bj) { const size_t o = (size_t)(t0 + ai * 128 + (2 * mp + m2) * 16) * 1024 + cl + bj * 128; xv[m2][bj][0] = *(const f32x4*)(x + o); xv[m2][bj][1] = *(const f32x4*)(x + o + 4); }
                __builtin_amdgcn_sched_barrier(0);
#pragma unroll
                for (int m2 = 0; m2 < 2; ++m2)
#pragma unroll
                    for (int bj = 0; bj < 2; ++bj) { const int m = 2 * mp + m2, t = t0 + ai * 128 + m * 16, cc = cl + bj * 128;
                        const f32x4 v0 = xv[m2][bj][0] + acc[ai][bj][m][0], v1 = xv[m2][bj][1] + acc[ai][bj][m][1];
                        const u32x4 hi = pack8(v0, v1); float hf[8]; unpack8(hi, hf);
                        const f32x4 l0 = {v0[0] - hf[0], v0[1] - hf[1], v0[2] - hf[2], v0[3] - hf[3]}, l1 = {v1[0] - hf[4], v1[1] - hf[5], v1[2] - hf[6], v1[3] - hf[7]};
                        *(u32x4*)(H1HI(hhi, t) + cc) = hi; *(u32x4*)(hlo + (size_t)t * 1024 + cc) = pack8(l0, l1); }
                __builtin_amdgcn_sched_barrier(0);
            }
    }
};
struct EpiE1 {
    const float* srstd; unsigned char* H;
    DI void operator()(const pg8::Acc& acc, const pg8::Unit& u, int wr, int wc, int fr, int fq) const {
        const int s0 = u.pm * 256 + wr * 64 + fr, col = u.pn * 128 + wc * 32 + 8 * fq;
        float rsv[2][4];
#pragma unroll
        for (int ai = 0; ai < 2; ++ai)
#pragma unroll
            for (int m = 0; m < 4; ++m) rsv[ai][m] = srstd[s0 + ai * 128 + m * 16] * (1.f / 32.f);
        __builtin_amdgcn_sched_barrier(0);
#pragma unroll
        EPI_LOOP_ROWS { const int s = s0 + ai * 128 + m * 16; const float rs = rsv[ai][m]; f32x4 r0, r1;
#pragma unroll
            for (int j = 0; j < 4; ++j) { r0[j] = siluf_(rs * acc[ai][0][m][0][j]) * (rs * acc[ai][1][m][0][j]); r1[j] = siluf_(rs * acc[ai][0][m][1][j]) * (rs * acc[ai][1][m][1][j]); }
            u32x2 w; w.x = pk4_fp8(r0[0], r0[1], r0[2], r0[3]); w.y = pk4_fp8(r1[0], r1[1], r1[2], r1[3]);
            *(u32x2*)(H + (size_t)s * 512 + col) = w; }
    }
};
struct EpiE2 {
    const float* sgate; unsigned char* Y;
    DI void operator()(const pg8::Acc& acc, const pg8::Unit& u, int wr, int wc, int fr, int fq) const {
        const int s0 = u.pm * 256 + wr * 64 + fr, cl = u.pn * 256 + wc * 32 + 8 * fq;
        float gv[2][4];
#pragma unroll
        for (int ai = 0; ai < 2; ++ai)
#pragma unroll
            for (int m = 0; m < 4; ++m) gv[ai][m] = sgate[s0 + ai * 128 + m * 16] * (8.f / 16.f);
        __builtin_amdgcn_sched_barrier(0);
#pragma unroll
        EPI_LOOP_ROWS { const int s = s0 + ai * 128 + m * 16; const float g = gv[ai][m]; unsigned char* yp = Y + (size_t)s * 1024 + cl;
#pragma unroll
            for (int bj = 0; bj < 2; ++bj) { const f32x4 a0 = acc[ai][bj][m][0] * g, a1 = acc[ai][bj][m][1] * g; u32x2 w; w.x = pk4_fp8(a0[0], a0[1], a0[2], a0[3]); w.y = pk4_fp8(a1[0], a1[1], a1[2], a1[3]);
                *(u32x2*)(yp + bj * 128) = w; } }
    }
};

DI void transpose_item(const float* __restrict__ W, int ldw, int c0, int c1, int k0, const float* __restrict__ kscale,
                       bf16* __restrict__ WT, size_t drow0, int ldk, LAS float* scr, int lane) {
    const int j = lane & 31, col = (j < 16) ? (c0 + j) : (c1 + j - 16);
#pragma unroll 8
    for (int i = 0; i < 32; ++i) { const int kk = 2 * i + (lane >> 5); float v = W[(size_t)(k0 + kk) * ldw + col]; if (kscale) v *= kscale[k0 + kk]; scr[kk * 33 + j] = v; }
    LDS_WAIT();
    const int c = lane & 7;
#pragma unroll
    for (int jj = 0; jj < 4; ++jj) { const int n = (lane >> 3) + 8 * jj; const LAS float* s = scr + (8 * c) * 33 + n;
        u32x4 o; o.x = pk2(s[0 * 33], s[1 * 33]); o.y = pk2(s[2 * 33], s[3 * 33]); o.z = pk2(s[4 * 33], s[5 * 33]); o.w = pk2(s[6 * 33], s[7 * 33]);
        *(u32x4*)(WT + (drow0 + n) * ldk + k0 + 8 * c) = o; }
    LDS_WAIT();
}

DI void transpose_item8(const float* __restrict__ W, int ldw, int c0, int c1, int k0, const float* __restrict__ kscale, float scale,
                        unsigned char* __restrict__ WT, size_t drow0, int ldk, LAS float* scr, int lane) {
    const int j = lane & 31, col = (j < 16) ? (c0 + j) : (c1 + j - 16);
#pragma unroll 8
    for (int i = 0; i < 32; ++i) { const int kk = 2 * i + (lane >> 5); float v = W[(size_t)(k0 + kk) * ldw + col] * scale; if (kscale) v *= kscale[k0 + kk]; scr[kk * 33 + j] = v; }
    LDS_WAIT();
    const int c = lane & 7;
#pragma unroll
    for (int jj = 0; jj < 4; ++jj) { const int n = (lane >> 3) + 8 * jj; const LAS float* s = scr + (8 * c) * 33 + n;
        u32x2 o; o.x = pk4_fp8(s[0 * 33], s[1 * 33], s[2 * 33], s[3 * 33]); o.y = pk4_fp8(s[4 * 33], s[5 * 33], s[6 * 33], s[7 * 33]);
        *(u32x2*)(WT + (drow0 + n) * ldk + k0 + 8 * c) = o; }
    LDS_WAIT();
}

struct P0Item { const float* src; unsigned char* dst; size_t drow0; int ldw, c0, c1, k0, fp8; };
DI P0Item p0_decode(const Params& P, int r) {
    constexpr int I_W1 = 161 * 16, I_ZR = 64 * 16, I_G = 64 * 16, I_P = 32 * 16;
    P0Item x; x.src = P.in[3]; x.ldw = 9248; x.fp8 = 0;
    if (r < I_W1) { const int nb = r >> 4, kb = r & 15;
        if (nb < 96) { x.c0 = 32 * nb; x.c1 = x.c0 + 16; } else if (nb < 160) { x.c0 = 4112 + 32 * (nb - 96); x.c1 = x.c0 + 16; } else { x.c0 = 4096; x.c1 = 7184; }
        x.k0 = 64 * kb; x.dst = P.ws + WS_W1T; x.drow0 = (size_t)32 * nb; return x; }
    r -= I_W1;
    if (r < I_ZR) { const int nb = r >> 4, kb = r & 15; x.c0 = (nb < 32) ? 3072 + 32 * nb : 6160 + 32 * (nb - 32); x.c1 = x.c0 + 16; x.k0 = 64 * kb; x.dst = P.ws + WS_WZR; x.drow0 = (size_t)32 * nb; return x; }
    r -= I_ZR;
    if (r < I_G) { const int nb = r >> 4, kb = r & 15, pn = nb >> 3, q = nb & 7; x.c0 = (q < 4) ? 7200 + 128 * pn + 32 * q : 8224 + 128 * pn + 32 * (q - 4); x.c1 = x.c0 + 16; x.k0 = 64 * kb;
        x.dst = P.ws + WS_WG; x.drow0 = (size_t)32 * nb; x.fp8 = 1; return x; }
    r -= I_G;
    { const int which = r / I_P, rr = r % I_P, nb = rr >> 4, kb = rr & 15;
        x.src = which == 0 ? P.in[8] : (which == 1 ? P.in[12] : P.in[13]); x.ldw = 1024; x.c0 = 32 * nb; x.c1 = x.c0 + 16; x.k0 = 64 * kb;
        x.dst = P.ws + (which == 0 ? WS_WPDN : (which == 1 ? WS_WPGLA : WS_WOUT)); x.drow0 = (size_t)32 * nb; x.fp8 = (which == 1); }
    return x;
}
DI void p0_load(const P0Item& x, f32x4 (&v)[8], int lane) {
    const int row = lane >> 3, col = (((lane >> 2) & 1) ? x.c1 : x.c0) + 4 * (lane & 3);
#pragma unroll
    for (int i = 0; i < 8; ++i) v[i] = *(const f32x4*)(x.src + (size_t)(x.k0 + 8 * i + row) * x.ldw + col);
}
DI void phase_p0(const Params& P, LAS unsigned char* lds) {
    int tid_o = threadIdx.x; asm volatile("" : "+v"(tid_o)); const int tid = tid_o, lane = tid & 63, wave = __builtin_amdgcn_readfirstlane(tid >> 6);
    const int gw = blockIdx.x * 8 + wave, NGW = gridDim.x * 8;
    LAS float* scr = (LAS float*)(lds + wave * 8448);
    unsigned char* ws = P.ws;
    const float* w_in = P.in[3];
    constexpr int I_W1 = 161 * 16, I_ZR = 64 * 16, I_G = 64 * 16, I_P = 32 * 16;
    constexpr int NITEMS = I_W1 + I_ZR + I_G + 3 * I_P;
    { f32x4 v[8];
        int it = gw;
        if (it < NITEMS) { const P0Item x0 = p0_decode(P, it); p0_load(x0, v, lane); }
#pragma nounroll
        for (; it < NITEMS; it += NGW) {
            { const int row = lane >> 3, j0 = ((lane >> 2) & 1) * 16 + 4 * (lane & 3);
#pragma unroll
                for (int i = 0; i < 8; ++i) { LAS float* d = scr + (8 * i + row) * 33 + j0; d[0] = v[i][0]; d[1] = v[i][1]; d[2] = v[i][2]; d[3] = v[i][3]; } }
            LDS_WAIT();
            if (it + NGW < NITEMS) { const P0Item nxt = p0_decode(P, it + NGW); p0_load(nxt, v, lane); }
            { const P0Item cur = p0_decode(P, it); const int c = lane & 7;
#pragma unroll
                for (int jj = 0; jj < 4; ++jj) { const int n = (lane >> 3) + 8 * jj; const LAS float* s = scr + (8 * c) * 33 + n;
                    if (cur.fp8) { u32x2 o; o.x = pk4_fp8(s[0 * 33] * 32.f, s[1 * 33] * 32.f, s[2 * 33] * 32.f, s[3 * 33] * 32.f); o.y = pk4_fp8(s[4 * 33] * 32.f, s[5 * 33] * 32.f, s[6 * 33] * 32.f, s[7 * 33] * 32.f);
                        *(u32x2*)(cur.dst + (cur.drow0 + n) * 1024 + cur.k0 + 8 * c) = o; }
                    else { u32x4 o; o.x = pk2(s[0 * 33], s[1 * 33]); o.y = pk2(s[2 * 33], s[3 * 33]); o.z = pk2(s[4 * 33], s[5 * 33]); o.w = pk2(s[6 * 33], s[7 * 33]);
                        *(u32x4*)((bf16*)cur.dst + (cur.drow0 + n) * 1024 + cur.k0 + 8 * c) = o; } } }
            LDS_WAIT();
        } }
    { u32x4* z = (u32x4*)(ws + WS_W1T + (size_t)5152 * 1024 * 2); const int n16 = 224 * 1024 * 2 / 16;
        for (int i = blockIdx.x * NTHREADS + tid; i < n16; i += gridDim.x * NTHREADS) z[i] = (u32x4){0u, 0u, 0u, 0u}; }
    { bf16* wh = (bf16*)(ws + WS_WRT); bf16* wl = wh + 80 * 1024; const float* nf = P.in[14]; const float* wg = P.in[15]; const float* wrt = P.in[17];
        for (int i = blockIdx.x * NTHREADS + tid; i < 1024 * 80; i += gridDim.x * NTHREADS) { const int n = i >> 10, k = i & 1023;
            const float v = (n < 8 ? wg[k * 8 + n] : (n < 16 ? 0.f : wrt[k * 64 + (n - 16)])) * nf[k]; const bf16 hi = f2bf(v); wh[i] = hi; wl[i] = f2bf(v - bf2f(hi)); } }
    bf16* xn = (bf16*)P.out; const float* x = P.in[0]; const float* meta = P.in[1]; const float* g = P.in[2]; unsigned char* xn8 = (unsigned char*)P.out + XN8_OFF;
    auto rowsrc = [&](int r) -> const float* { const int b = r / LP, p = r - b * LP; return p < 48 ? nullptr : (p < 64 ? meta + (size_t)(p - 48) * 1024 : x + ((size_t)b * SEQ + (p - 64)) * 1024); };
    f32x4 gv[4];
#pragma unroll
    for (int j = 0; j < 4; ++j) gv[j] = ((const f32x4*)g)[lane + 64 * j];
    f32x4 vn[4], vm[4]; const float* sn = nullptr; const float* sm = nullptr; int r = gw;
    if (r < TP) { sn = rowsrc(r); if (sn) {
#pragma unroll
        for (int j = 0; j < 4; ++j) vn[j] = ((const f32x4*)sn)[lane + 64 * j]; } }
    if (r + NGW < TP) { sm = rowsrc(r + NGW); if (sm) {
#pragma unroll
        for (int j = 0; j < 4; ++j) vm[j] = ((const f32x4*)sm)[lane + 64 * j]; } }
    for (; r < TP; r += NGW) {
        f32x4 v[4]; const float* sc = sn;
#pragma unroll
        for (int j = 0; j < 4; ++j) { v[j] = vn[j]; vn[j] = vm[j]; }
        sn = sm;
        const int rn = r + 2 * NGW; sm = nullptr;
        if (rn < TP) { sm = rowsrc(rn); if (sm) {
#pragma unroll
            for (int j = 0; j < 4; ++j) vm[j] = ((const f32x4*)sm)[lane + 64 * j]; } }
        unsigned long long* o8 = (unsigned long long*)(xn + (size_t)r * 1024) + lane; unsigned* o4 = (unsigned*)(xn8 + (size_t)r * 1024) + lane;
        if (!sc) {
#pragma unroll
            for (int j = 0; j < 4; ++j) { o8[64 * j] = 0ull; o4[64 * j] = 0u; }
            continue; }
        float s = 0.f;
#pragma unroll
        for (int j = 0; j < 4; ++j) s += (v[j][0] * v[j][0] + v[j][1] * v[j][1]) + (v[j][2] * v[j][2] + v[j][3] * v[j][3]);
        const float rs = rsqrtf(wave_sum(s) * (1.f / 1024.f) + EPS);
#pragma unroll
        for (int j = 0; j < 4; ++j) { const f32x4 gg = gv[j];
            o8[64 * j] = (unsigned long long)pk2(v[j][0] * rs * gg[0], v[j][1] * rs * gg[1]) | ((unsigned long long)pk2(v[j][2] * rs * gg[2], v[j][3] * rs * gg[3]) << 32);
            o4[64 * j] = pk4_fp8(v[j][0] * rs * gg[0], v[j][1] * rs * gg[1], v[j][2] * rs * gg[2], v[j][3] * rs * gg[3]); }
    }
}

struct PxItem { const float* src; unsigned char* dst; size_t drow0; int ldw, c0, k0, ldk, hasks; float sc; };
DI PxItem px_decode(const Params& P, int it) {
    constexpr int I13 = 32 * 16, I2 = 32 * 8;
    PxItem x; const int e = it / (I13 + I2); int r = it % (I13 + I2);
    if (r < I13) { const int nb = r >> 4, kb = r & 15, pn = nb >> 3, q = nb & 7; x.src = (q < 4 ? P.in[19] : P.in[20]) + (size_t)e * 1024 * 512; x.ldw = 512; x.c0 = 128 * pn + 32 * (q & 3); x.k0 = 64 * kb;
        x.hasks = 1; x.sc = 32.f; x.dst = P.ws + WS_WEXP13 + (size_t)e * 1024 * 1024; x.drow0 = (size_t)32 * nb; x.ldk = 1024; }
    else { r -= I13; const int nb = r >> 3, kb = r & 7; x.src = P.in[21] + (size_t)e * 512 * 1024; x.ldw = 1024; x.c0 = 32 * nb; x.k0 = 64 * kb;
        x.hasks = 0; x.sc = 16.f; x.dst = P.ws + WS_WEXP2 + (size_t)e * 1024 * 512; x.drow0 = (size_t)32 * nb; x.ldk = 512; }
    return x;
}
DI void px_load(const PxItem& x, const float* nf, f32x4 (&v)[8], float (&ksv)[8], int lane) {
    const int row = lane >> 3, col = x.c0 + ((lane >> 2) & 1) * 16 + 4 * (lane & 3);
#pragma unroll
    for (int i = 0; i < 8; ++i) { v[i] = *(const f32x4*)(x.src + (size_t)(x.k0 + 8 * i + row) * x.ldw + col); ksv[i] = nf[x.k0 + 8 * i + row]; }
}
DI void phase_px(const Params& P, LAS unsigned char* lds, const bool split) {
    int tid_o = threadIdx.x; asm volatile("" : "+v"(tid_o)); const int tid = tid_o, lane = tid & 63, wave = __builtin_amdgcn_readfirstlane(tid >> 6);
    if (split && ((blockIdx.x >> 3) & 1)) return;
    const int gw = split ? (int)(((blockIdx.x & 7) | ((blockIdx.x >> 4) << 3)) * 8 + wave) : (int)(blockIdx.x * 8 + wave), NGW = split ? 1024 : (int)gridDim.x * 8;
    LAS float* scr = (LAS float*)(lds + wave * 8448);
    constexpr int NIT = 64 * (32 * 16 + 32 * 8);
    const float* nf = P.in[14];
    f32x4 va[8], vb[8]; float ka[8], kb[8];
#define PX_PROCESS(v_, k_, it_, nxt_) { \
        { const PxItem cur = px_decode(P, (it_)); const int row = lane >> 3, j0 = ((lane >> 2) & 1) * 16 + 4 * (lane & 3); \
            _Pragma("unroll") for (int i = 0; i < 8; ++i) { LAS float* d = scr + (8 * i + row) * 33 + j0; const float g = cur.hasks ? k_[i] * cur.sc : cur.sc; d[0] = v_[i][0] * g; d[1] = v_[i][1] * g; d[2] = v_[i][2] * g; d[3] = v_[i][3] * g; } } \
        LDS_WAIT(); \
        if ((nxt_) < NIT) { const PxItem nxt = px_decode(P, (nxt_)); px_load(nxt, nf, v_, k_, lane); } \
        { const PxItem cur = px_decode(P, (it_)); const int c = lane & 7; \
            _Pragma("unroll") for (int jj = 0; jj < 4; ++jj) { const int n = (lane >> 3) + 8 * jj; const LAS float* s = scr + (8 * c) * 33 + n; \
                u32x2 o; o.x = pk4_fp8(s[0 * 33], s[1 * 33], s[2 * 33], s[3 * 33]); o.y = pk4_fp8(s[4 * 33], s[5 * 33], s[6 * 33], s[7 * 33]); \
                *(u32x2*)(cur.dst + (cur.drow0 + n) * cur.ldk + cur.k0 + 8 * c) = o; } } \
        LDS_WAIT(); }
    if (gw < NIT) { const PxItem x0 = px_decode(P, gw); px_load(x0, nf, va, ka, lane); }
    if (gw + NGW < NIT) { const PxItem x1 = px_decode(P, gw + NGW); px_load(x1, nf, vb, kb, lane); }
#pragma nounroll
    for (int it = gw; it < NIT; it += 2 * NGW) {
        PX_PROCESS(va, ka, it, it + 2 * NGW)
        if (it + NGW < NIT) PX_PROCESS(vb, kb, it + NGW, it + 3 * NGW)
    }
#undef PX_PROCESS
}

#define MFMA32(a, b, c) __builtin_amdgcn_mfma_f32_32x32x16_bf16((a), (b), (c), 0, 0, 0)
#define MFMA16(a, b, c) __builtin_amdgcn_mfma_f32_16x16x32_bf16((a), (b), (c), 0, 0, 0)
DI bf16x8 lds_rowfrag(const LAS unsigned char* tile, int pitchB, int row, int k0) { return *(const LAS bf16x8*)(tile + row * pitchB + k0 * 2); }
DI bf16x8 lds_colfrag(const LAS unsigned char* tile, int pitchB, int col, int k0) {
    const LAS bf16* p = (const LAS bf16*)(tile + k0 * pitchB) + col; const int ps = pitchB / 2; u32x4 w;
    w.x = (unsigned)p[0] | ((unsigned)p[ps] << 16); w.y = (unsigned)p[2 * ps] | ((unsigned)p[3 * ps] << 16);
    w.z = (unsigned)p[4 * ps] | ((unsigned)p[5 * ps] << 16); w.w = (unsigned)p[6 * ps] | ((unsigned)p[7 * ps] << 16);
    return __builtin_bit_cast(bf16x8, w);
}
constexpr int PD_RAW = 0, PD_AM = 0, PD_QT = 51456, PD_KT = PD_QT + 17408, PD_VT = PD_KT + 17408, PD_SC = PD_VT + 17408, PD_CW = PD_SC + 1536, PD_TD = PD_CW + 6144, PD_UT = PD_TD + 2048, PD_WS = PD_UT + 4 * 4608;
static_assert(PD_WS + 4 * 5120 <= LDS_BYTES - 64, "prep_dn LDS map");
DI bf16x8 packacc(const f32x4& a, const f32x4& b) { u32x4 w; w.x = pk2(a[0], a[1]); w.y = pk2(a[2], a[3]); w.z = pk2(b[0], b[1]); w.w = pk2(b[2], b[3]); return __builtin_bit_cast(bf16x8, w); }
#define MFMAF(a, b, c) __builtin_amdgcn_mfma_f32_16x16x4f32((a), (b), (c), 0, 0, 0)

DI void prep_dn_phase(const Params& P, LAS unsigned char* lds) {
    int tid_o = threadIdx.x; asm volatile("" : "+v"(tid_o)); const int tid = tid_o, lane = tid & 63, wave = __builtin_amdgcn_readfirstlane(tid >> 6);
    const int G = gridDim.x;
    bf16* pdn = (bf16*)(P.ws + WS_PDN); const bf16* halo = (const bf16*)(P.ws + WS_HALO); const float* small = (const float*)(P.ws + WS_SMALL);
    LAS float* SC = (LAS float*)(lds + PD_SC);
    LAS float* AM = (LAS float*)(lds + PD_AM);
    LAS float* CW = (LAS float*)(lds + PD_CW);
    u32x4 pf[7]; f32x4 pfw; float pfa = 0.f, pfb = 0.f;
#define PDN_PREFETCH(it_) do { const int h_ = (it_) & 7, gch_ = (it_) >> 3, c_ = gch_ % NCH, R0_ = gch_ * 64; \
        _Pragma("unroll") for (int q_ = 0; q_ < 7; ++q_) { const int p_ = tid + 512 * q_; pf[q_] = (u32x4){0u, 0u, 0u, 0u}; \
            if (p_ < 3216) { const int row_ = p_ / 48, rem_ = p_ - row_ * 48, seg_ = rem_ >> 4, c16_ = rem_ & 15; \
                if (row_ >= 3) pf[q_] = *(const u32x4*)(pdn + (size_t)(R0_ + row_ - 3) * 3072 + seg_ * 1024 + h_ * 128 + c16_ * 8); \
                else if (c_ > 0) pf[q_] = *(const u32x4*)(halo + ((size_t)(gch_ - 1) * 3 + row_) * 3072 + seg_ * 1024 + h_ * 128 + c16_ * 8); } } \
        if (tid < 384) { const int j_ = tid / 96, r_ = tid - j_ * 96, seg_ = r_ >> 5, c4_ = r_ & 31; pfw = *(const f32x4*)(P.in[4] + j_ * 3072 + seg_ * 1024 + h_ * 128 + c4_ * 4); } \
        if (tid < 64) { pfa = small[(size_t)(R0_ + tid) * 32 + h_]; pfb = small[(size_t)(R0_ + tid) * 32 + 8 + h_]; } } while (0)
    const bool swz = (G == 256);
#define PDN_ITEM(k_) (swz ? ((((k_) * 8 + (blockIdx.x & 7)) * 4 + (blockIdx.x >> 6)) * 8 + ((blockIdx.x >> 3) & 7)) : ((int)blockIdx.x + (k_) * G))
    const int nk = swz ? NIT_DN / 256 : ((int)blockIdx.x < NIT_DN ? (NIT_DN - (int)blockIdx.x + G - 1) / G : 0);
    if (nk > 0) PDN_PREFETCH(PDN_ITEM(0));
#pragma nounroll
    for (int kk = 0; kk < nk; ++kk) { const int item = PDN_ITEM(kk);
        const int h = item & 7, gch = item >> 3, c = gch % NCH; const int R0 = gch * 64;
        unsigned char* ext = P.ws + WS_EXT + (size_t)item * 24576; float* scdn = (float*)(P.ws + WS_SC_DN) + (size_t)item * 80;
#pragma unroll
        for (int q = 0; q < 7; ++q) { const int p = tid + 512 * q; if (p < 3216) { const int row = p / 48, rem = p - row * 48; *(LAS u32x4*)(lds + PD_RAW + row * 768 + rem * 16) = pf[q]; } }
        if (tid < 384) { const int j = tid / 96, r = tid - j * 96; *(LAS f32x4*)(CW + j * 384 + r * 4) = pfw; }
        if (tid < 64) {
            const bool pad = (c == 0 && tid < 48);
            float g = pad ? 0.f : -__expf(P.in[5][h]) * softplusf_(pfa + P.in[6][h]);
            const float beta = pad ? 0.f : sigmoidf_(pfb);
#pragma unroll
            for (int o = 1; o < 64; o <<= 1) { const float t = __shfl_up(g, o); if (lane >= o) g += t; }
            SC[tid] = g; SC[64 + tid] = beta; SC[256 + tid] = __expf(g);
            const float gl = __shfl(g, 63);
            scdn[tid] = __expf(gl - g); if (tid == 0) scdn[64] = __expf(gl);
        }
        __syncthreads();
        if (kk + 1 < nk) PDN_PREFETCH(PDN_ITEM(kk + 1));
#pragma unroll
        for (int rnd = 0; rnd < 3; ++rnd) { const int idx = tid + 512 * rnd; const int rg = idx / 192, cp = idx - rg * 192, tsr = cp >> 6, colp = cp & 63;
            float w0[4], w1[4];
#pragma unroll
            for (int j = 0; j < 4; ++j) { w0[j] = CW[j * 384 + 2 * cp]; w1[j] = CW[j * 384 + 2 * cp + 1]; }
            const LAS unsigned char* rp = lds + PD_RAW + (8 * rg) * 768 + cp * 4;
            float r0[3], r1[3];
#pragma unroll
            for (int j = 0; j < 3; ++j) { const unsigned v = *(const LAS unsigned*)(rp + j * 768); r0[j] = bflo(v); r1[j] = bfhi(v); }
            LAS unsigned char* tile = lds + PD_QT + tsr * 17408;
#pragma unroll
            for (int ii = 0; ii < 8; ++ii) { const unsigned v = *(const LAS unsigned*)(rp + (3 + ii) * 768); const float x0 = bflo(v), x1 = bfhi(v);
                const float o0 = w0[0] * r0[0] + w0[1] * r0[1] + w0[2] * r0[2] + w0[3] * x0, o1 = w1[0] * r1[0] + w1[1] * r1[1] + w1[2] * r1[2] + w1[3] * x1;
                r0[0] = r0[1]; r0[1] = r0[2]; r0[2] = x0; r1[0] = r1[1]; r1[1] = r1[2]; r1[2] = x1;
                *(LAS unsigned*)(tile + (8 * rg + ii) * 272 + 4 * colp) = pk2(siluf_(o0), siluf_(o1)); } }
        __syncthreads();
        { const int i = tid >> 3, part = tid & 7; const LAS unsigned char* qp = lds + PD_QT + i * 272 + part * 32; const LAS unsigned char* kp = lds + PD_KT + i * 272 + part * 32;
            float sq = 0.f, sk = 0.f;
#pragma unroll
            for (int j = 0; j < 2; ++j) { float f[8]; unpack8(*(const LAS u32x4*)(qp + 16 * j), f);
#pragma unroll
                for (int e = 0; e < 8; ++e) sq += f[e] * f[e];
                unpack8(*(const LAS u32x4*)(kp + 16 * j), f);
#pragma unroll
                for (int e = 0; e < 8; ++e) sk += f[e] * f[e]; }
            sq += __shfl_xor(sq, 1); sq += __shfl_xor(sq, 2); sq += __shfl_xor(sq, 4); sk += __shfl_xor(sk, 1); sk += __shfl_xor(sk, 2); sk += __shfl_xor(sk, 4);
            if (part == 0) { SC[128 + i] = rsqrtf(sq + EPS) * 0.08838834764831845f; SC[192 + i] = rsqrtf(sk + EPS); } }
        __syncthreads();
        { const int which = wave >> 2, qd = wave & 3, r = lane & 31, hh = lane >> 5;
            f32x16 acc;
#pragma unroll
            for (int e = 0; e < 16; ++e) acc[e] = 0.f;
            if (which == 0) { const int qi = qd >> 1, qj = qd & 1;
                if (!(qi == 0 && qj == 1)) {
#pragma unroll
                    for (int s = 0; s < 8; ++s) acc = MFMA32(lds_rowfrag(lds + PD_KT, 272, 32 * qi + r, 16 * s + 8 * hh), lds_rowfrag(lds + PD_KT, 272, 32 * qj + r, 16 * s + 8 * hh), acc); }
                const int j = 32 * qj + r; const float gcj = SC[j], rkj = SC[192 + j];
#pragma unroll
                for (int reg = 0; reg < 16; ++reg) { const int i = 32 * qi + (reg & 3) + 8 * (reg >> 2) + 4 * hh;
                    AM[i * 68 + j] = (i > j) ? SC[64 + i] * acc[reg] * SC[192 + i] * rkj * __expf(SC[i] - gcj) : 0.f; }
            } else { const int qj = qd >> 1, qi = qd & 1;
                if (!(qi == 0 && qj == 1)) {
#pragma unroll
                    for (int s = 0; s < 8; ++s) acc = MFMA32(lds_rowfrag(lds + PD_KT, 272, 32 * qj + r, 16 * s + 8 * hh), lds_rowfrag(lds + PD_QT, 272, 32 * qi + r, 16 * s + 8 * hh), acc); }
                const int i = 32 * qi + r; const float gci = SC[i], rqi = SC[128 + i]; bf16* qkg = (bf16*)(ext + 16384);
#pragma unroll
                for (int g4 = 0; g4 < 4; ++g4) { const int j0 = 32 * qj + 8 * g4 + 4 * hh; float v[4];
#pragma unroll
                    for (int e = 0; e < 4; ++e) { const int j = j0 + e; v[e] = (i >= j) ? acc[4 * g4 + e] * rqi * SC[192 + j] * __expf(gci - SC[j]) : 0.f; }
                    u32x2 w; w.x = pk2(v[0], v[1]); w.y = pk2(v[2], v[3]); *(u32x2*)(qkg + i * 64 + j0) = w; } } }
        __syncthreads();
        if (wave != 0)
        for (int p = tid - 64; p < 2048; p += NTHREADS - 64) {
            if (p < 1024) { const int i = p >> 4, d0 = (p & 15) * 8; float f[8]; unpack8(*(const LAS u32x4*)(lds + PD_QT + i * 272 + d0 * 2), f);
                const float sc = SC[128 + i] * SC[256 + i]; f32x4 a = {f[0] * sc, f[1] * sc, f[2] * sc, f[3] * sc}, b = {f[4] * sc, f[5] * sc, f[6] * sc, f[7] * sc};
                *(u32x4*)(pdn + (size_t)(R0 + i) * 3072 + h * 128 + d0) = pack8(a, b); }
            else { const int pp = p - 1024, d = pp >> 3, ig = pp & 7; const LAS bf16* kp = (const LAS bf16*)(lds + PD_KT) + (8 * ig) * 136 + d; float f[8];
#pragma unroll
                for (int e = 0; e < 8; ++e) f[e] = bf2f(kp[e * 136]) * SC[192 + 8 * ig + e];
                f32x4 a = {f[0], f[1], f[2], f[3]}, b = {f[4], f[5], f[6], f[7]};
                *(u32x4*)(pdn + (size_t)(R0 + (d >> 1)) * 3072 + 1024 + h * 128 + (d & 1) * 64 + 8 * ig) = pack8(a, b); }
        }
        if (wave == 0) {
            LAS bf16* TDw = (LAS bf16*)(lds + PD_TD);
            { int vz; asm volatile("v_mov_b32 %0, 0" : "=v"(vz));
                const int blk = lane >> 4, jj = lane & 15; const LAS float* Ab = AM + vz + (16 * blk) * 68 + 16 * blk;
                float t[16]; const float jf = (float)(jj + vz);
#pragma unroll
                for (int i = 0; i < 16; ++i) { float s = 1.f - fminf(fabsf(jf - (float)i), 1.f);
#pragma unroll
                    for (int k4 = 0; k4 < (i + 3) / 4; ++k4) { const f32x4 a = *(const LAS f32x4*)(Ab + i * 68 + 4 * k4);
#pragma unroll
                        for (int cc = 0; cc < 4; ++cc) if (4 * k4 + cc < i) s -= a[cc] * t[4 * k4 + cc]; }
                    t[i] = s; }
#pragma unroll
                for (int i = 0; i < 16; ++i) TDw[(16 * blk + i) * 16 + jj] = f2bf(t[i]); }
        }
        __syncthreads();
        {
            int lane_o = lane; asm volatile("" : "+v"(lane_o)); const int lane = lane_o;
            const LAS bf16* TDw = (const LAS bf16*)(lds + PD_TD);
            const int which = wave >> 2, idx4 = wave & 3, m = lane & 15, kq = lane >> 4;
            bf16x8 Top[4], Aop[4];
#pragma unroll
            for (int bb = 0; bb < 4; ++bb) { const u32x2 lo = *(const LAS u32x2*)(TDw + (16 * bb + m) * 16 + 4 * kq); u32x4 w; w.x = lo.x; w.y = lo.y; w.z = 0u; w.w = 0u; Top[bb] = __builtin_bit_cast(bf16x8, w); }
            { const f32x4 z4 = {0.f, 0.f, 0.f, 0.f};
                const LAS float* r1 = AM + (16 + m) * 68 + 4 * kq; const LAS float* r2 = AM + (32 + m) * 68 + 4 * kq; const LAS float* r3 = AM + (48 + m) * 68 + 4 * kq;
                Aop[0] = packacc(-*(const LAS f32x4*)r1, z4); Aop[1] = packacc(-*(const LAS f32x4*)r2, -*(const LAS f32x4*)(r2 + 16));
                Aop[2] = packacc(-*(const LAS f32x4*)r3, -*(const LAS f32x4*)(r3 + 16)); Aop[3] = packacc(-*(const LAS f32x4*)(r3 + 32), z4); }
            float scv[4][4];
#pragma unroll
            for (int i = 0; i < 4; ++i)
#pragma unroll
                for (int reg = 0; reg < 4; ++reg) { const int row = 16 * i + 4 * kq + reg; scv[i][reg] = which == 0 ? SC[64 + row] : SC[64 + row] * SC[192 + row] * SC[256 + row]; }
            const LAS unsigned char* RT = lds + (which == 0 ? PD_VT : PD_KT);
            LAS bf16* UTw = (LAS bf16*)(lds + PD_UT + idx4 * 4608);
            LAS bf16* WTw = (LAS bf16*)(lds + PD_WS + idx4 * 5120);
            const f32x4 z4 = {0.f, 0.f, 0.f, 0.f};
#pragma unroll
            for (int nt = 0; nt < 2; ++nt) { const int e = 32 * idx4 + 16 * nt + m;
                f32x4 Bv[4];
#pragma unroll
                for (int i = 0; i < 4; ++i)
#pragma unroll
                    for (int reg = 0; reg < 4; ++reg) Bv[i][reg] = bf2f(*(const LAS bf16*)(RT + (16 * i + 4 * kq + reg) * 272 + e * 2)) * scv[i][reg];
                f32x4 U[4];
                U[0] = MFMA16(Top[0], packacc(Bv[0], z4), z4);
                { const f32x4 R = MFMA16(Aop[0], packacc(U[0], z4), Bv[1]); U[1] = MFMA16(Top[1], packacc(R, z4), z4); }
                { const f32x4 R = MFMA16(Aop[1], packacc(U[0], U[1]), Bv[2]); U[2] = MFMA16(Top[2], packacc(R, z4), z4); }
                { f32x4 R = MFMA16(Aop[2], packacc(U[0], U[1]), Bv[3]); R = MFMA16(Aop[3], packacc(U[2], z4), R); U[3] = MFMA16(Top[3], packacc(R, z4), z4); }
                if (which == 0) {
#pragma unroll
                    for (int i = 0; i < 4; ++i) { u32x2 w; w.x = pk2(U[i][0], U[i][1]); w.y = pk2(U[i][2], U[i][3]); *(LAS u32x2*)(UTw + (16 * nt + m) * 72 + 16 * i + 4 * kq) = w; }
                } else {
#pragma unroll
                    for (int i = 0; i < 4; ++i)
#pragma unroll
                        for (int reg = 0; reg < 4; ++reg) WTw[(16 * i + 4 * kq + reg) * 40 + 16 * nt + m] = f2bf(-U[i][reg]);
                } }
            if (which == 0) { LDS_WAIT();
#pragma unroll
                for (int it4 = 0; it4 < 4; ++it4) { const int rl = 8 * it4 + (lane >> 3), pc = lane & 7, e = 32 * idx4 + rl;
                    *(u32x4*)(pdn + (size_t)(R0 + (e >> 1)) * 3072 + 2048 + h * 128 + (e & 1) * 64 + 8 * pc) = *(const LAS u32x4*)(UTw + rl * 72 + 8 * pc); } }
            if (which == 1) { LDS_WAIT(); bf16* wn = (bf16*)ext;
#pragma unroll
                for (int it4 = 0; it4 < 4; ++it4) { const int cc = 16 * it4 + (lane >> 2), pc = lane & 3;
                    *(u32x4*)(wn + cc * 128 + 32 * idx4 + 8 * pc) = *(const LAS u32x4*)(WTw + cc * 40 + 8 * pc); } }
        }
        __syncthreads();
    }
#undef PDN_PREFETCH
#undef PDN_ITEM
}

constexpr int WLDS = 20480;
DI void prep_gla_wave(const Params& P, LAS unsigned char* wl, int item, int lane) {
    const int h = item & 3, gch = item >> 2, c = gch % NCH; const int R0 = gch * 64;
    bf16* pg = (bf16*)(P.ws + WS_PGLA); const float* small = (const float*)(P.ws + WS_SMALL);
    const int d0 = 2 * lane;
    f32x2_t wa[16];
#pragma unroll
    for (int r = 0; r < 16; ++r) wa[r] = *(const f32x2_t*)(P.in[9] + r * 512 + h * 128 + d0);
    const f32x2_t ba = *(const f32x2_t*)(P.in[10] + h * 128 + d0);
    float b0 = 0.f, b1 = 0.f;
    bf16* qrow = pg + (size_t)R0 * 2048 + h * 128 + d0;
    bf16* kt0 = pg + (size_t)(R0 + lane) * 2048 + 512 + h * 128;
    f32x4 lrv[4];
#pragma unroll
    for (int q = 0; q < 4; ++q) lrv[q] = *(const f32x4*)(small + (size_t)(R0 + lane) * 32 + 16 + 4 * q);
    int vz; asm volatile("v_mov_b32 %0, 0" : "=v"(vz));
    const LAS float* LRB = (const LAS float*)(wl + 17408) + vz;
#pragma unroll
    for (int i8 = 0; i8 < 8; ++i8) {
        unsigned qv[8], kv[8];
#pragma unroll
        for (int e = 0; e < 8; ++e) { const bf16* p = qrow + (size_t)(8 * i8 + e) * 2048; qv[e] = *(const unsigned*)p; kv[e] = *(const unsigned*)(p + 512); }
        if ((lane >> 3) == i8) {
#pragma unroll
            for (int q = 0; q < 4; ++q) *(LAS f32x4*)((LAS float*)(wl + 17408) + (lane & 7) * 16 + 4 * q) = lrv[q]; }
        asm volatile("" ::: "memory");
        float ka0[8], ka1[8];
#pragma unroll
        for (int e = 0; e < 8; ++e) { const int i = 8 * i8 + e;
            f32x2_t xx = ba;
#pragma unroll
            for (int r4 = 0; r4 < 4; ++r4) { const f32x4 l = *(const LAS f32x4*)(LRB + e * 16 + 4 * r4);
#pragma unroll
                for (int rr = 0; rr < 4; ++rr) { const f32x2_t lb = {l[rr], l[rr]}; xx = __builtin_elementwise_fma(lb, wa[4 * r4 + rr], xx); } }
            const float x0 = xx[0], x1 = xx[1];
            const bool pad = (c == 0 && i < 48);
            b0 += pad ? 0.f : logsigmoidf_(x0) * (1.f / 16.f); b1 += pad ? 0.f : logsigmoidf_(x1) * (1.f / 16.f);
            const float E0 = __expf(b0), E1 = __expf(b1), I0 = __builtin_amdgcn_rcpf(E0), I1 = __builtin_amdgcn_rcpf(E1);
            const unsigned q = pk2(bflo(qv[e]) * 0.08838834764831845f * E0, bfhi(qv[e]) * 0.08838834764831845f * E1);
            *(unsigned*)(qrow + (size_t)i * 2048) = q;
            ka0[e] = bflo(kv[e]) * I0; ka1[e] = bfhi(kv[e]) * I1;
            *(LAS unsigned*)(wl + i * 272 + 4 * lane) = pk2(ka0[e], ka1[e]); }
    }
    asm volatile("" ::: "memory");
#pragma unroll
    for (int i8 = 0; i8 < 8; ++i8) { unsigned v[8];
#pragma unroll
        for (int e = 0; e < 8; ++e) v[e] = *(const LAS unsigned*)(wl + (8 * i8 + e) * 272 + 4 * lane);
        u32x4 w0, w1;
        w0.x = (v[0] & 0xffffu) | (v[1] << 16); w0.y = (v[2] & 0xffffu) | (v[3] << 16); w0.z = (v[4] & 0xffffu) | (v[5] << 16); w0.w = (v[6] & 0xffffu) | (v[7] << 16);
        w1.x = (v[0] >> 16) | (v[1] & 0xffff0000u); w1.y = (v[2] >> 16) | (v[3] & 0xffff0000u); w1.z = (v[4] >> 16) | (v[5] & 0xffff0000u); w1.w = (v[6] >> 16) | (v[7] & 0xffff0000u);
        *(u32x4*)(kt0 + 8 * i8) = w0; *(u32x4*)(kt0 + 64 + 8 * i8) = w1; }
    { f32x2_t eb = {__expf(b0), __expf(b1)}; *(f32x2_t*)((float*)(P.ws + WS_EBL) + (size_t)item * 128 + d0) = eb; }
    const int r = lane & 31, hh = lane >> 5;
    bf16x8 kf[2][8];
#pragma unroll
    for (int qj = 0; qj < 2; ++qj)
#pragma unroll
        for (int s = 0; s < 8; ++s) kf[qj][s] = lds_rowfrag(wl, 272, 32 * qj + r, 16 * s + 8 * hh);
    asm volatile("s_waitcnt vmcnt(0)" ::: "memory");
#pragma unroll
    for (int i16 = 0; i16 < 4; ++i16) { unsigned qq[16];
#pragma unroll
        for (int e = 0; e < 16; ++e) qq[e] = __hip_atomic_load((const unsigned*)(qrow + (size_t)(16 * i16 + e) * 2048), __ATOMIC_RELAXED, __HIP_MEMORY_SCOPE_AGENT);
#pragma unroll
        for (int e = 0; e < 16; ++e) *(LAS unsigned*)(wl + (16 * i16 + e) * 272 + 4 * lane) = qq[e]; }
    bf16* att = (bf16*)(P.ws + WS_ATT + (size_t)item * 8192);
#pragma unroll
    for (int qd3 = 0; qd3 < 3; ++qd3) { const int qj = qd3 >> 1, qi = (qd3 + 1) >> 1;
        f32x16 acc;
#pragma unroll
        for (int e = 0; e < 16; ++e) acc[e] = 0.f;
#pragma unroll
        for (int s = 0; s < 8; ++s) acc = MFMA32(kf[qj][s], lds_rowfrag(wl, 272, 32 * qi + r, 16 * s + 8 * hh), acc);
        const int i = 32 * qi + r;
#pragma unroll
        for (int g4 = 0; g4 < 4; ++g4) { const int j0 = 32 * qj + 8 * g4 + 4 * hh; float v[4];
#pragma unroll
            for (int e = 0; e < 4; ++e) v[e] = (i >= j0 + e) ? acc[4 * g4 + e] : 0.f;
            u32x2 w; w.x = pk2(v[0], v[1]); w.y = pk2(v[2], v[3]); *(u32x2*)(att + i * 64 + j0) = w; } }
#pragma unroll
    for (int g4 = 0; g4 < 4; ++g4) { u32x2 z = {0u, 0u}; *(u32x2*)(att + r * 64 + 32 + 8 * g4 + 4 * hh) = z; }
    asm volatile("" ::: "memory");
}
DI void prep_gla_phase(const Params& P, LAS unsigned char* lds) {
    int tid_o = threadIdx.x; asm volatile("" : "+v"(tid_o)); const int tid = tid_o, lane = tid & 63, wave = __builtin_amdgcn_readfirstlane(tid >> 6);
    LAS unsigned char* wl = lds + wave * WLDS;
    for (int item = blockIdx.x + gridDim.x * wave; item < NIT_GLA; item += gridDim.x * 8) prep_gla_wave(P, wl, item, lane);
}

DI bf16x8 frag2(const LAS unsigned char* tile, int pitchB, int row, int c0) {
    const u32x2 lo = *(const LAS u32x2*)(tile + row * pitchB + c0 * 2), hi = *(const LAS u32x2*)(tile + row * pitchB + (c0 + 16) * 2);
    u32x4 w; w.x = lo.x; w.y = lo.y; w.z = hi.x; w.w = hi.y; return __builtin_bit_cast(bf16x8, w);
}
constexpr int SC_WN = 0, SC_QD = 17408, SC_QK = 34816, SC_KT = 44032, SC_BUF = 62464, SC_DK = 124928, SC_SSQ = 125952;

DI bf16x8 frag32(const LAS unsigned char* tile, int pitchB, int row, int k0, int hh) {
    const u32x2 lo = *(const LAS u32x2*)(tile + row * pitchB + (k0 + 4 * hh) * 2), hi = *(const LAS u32x2*)(tile + row * pitchB + (k0 + 8 + 4 * hh) * 2);
    u32x4 w; w.x = lo.x; w.y = lo.y; w.z = hi.x; w.w = hi.y; return __builtin_bit_cast(bf16x8, w);
}
DI bf16x8 packacc8(const f32x16& x, int h2) { u32x4 w; w.x = pk2(x[8 * h2], x[8 * h2 + 1]); w.y = pk2(x[8 * h2 + 2], x[8 * h2 + 3]); w.z = pk2(x[8 * h2 + 4], x[8 * h2 + 5]); w.w = pk2(x[8 * h2 + 6], x[8 * h2 + 7]); return __builtin_bit_cast(bf16x8, w); }

#define SBAR() asm volatile("s_waitcnt lgkmcnt(0)\n\ts_barrier" ::: "memory")
DI void scan_dn_item(const Params& P, LAS unsigned char* lds, int item) {
    int tid_o = threadIdx.x; asm volatile("" : "+v"(tid_o)); const int tid = tid_o, lane = tid & 63, wave = __builtin_amdgcn_readfirstlane(tid >> 6);
    const int b = item >> 3, h = item & 7, r = lane & 31, hh = lane >> 5, e0 = 32 * (wave & 3);
    const bool comp = wave < 4; const int lt = tid - 256;
    bf16* pdn = (bf16*)(P.ws + WS_PDN); float* ssqg = (float*)(P.ws + WS_SSQ_DN);
#define SDN_LOAD(cc, st, stdk) do { const int gch_ = b * NCH + (cc); const int R0_ = gch_ * 64; const unsigned char* ext_ = P.ws + WS_EXT + (size_t)(gch_ * 8 + h) * 24576; \
        _Pragma("unroll") for (int j_ = 0; j_ < 4; ++j_) { const int p_ = lt + 256 * j_; st[j_] = *(const u32x4*)(ext_ + (size_t)p_ * 16); \
            st[4 + j_] = *(const u32x4*)(pdn + (size_t)(R0_ + (p_ >> 4)) * 3072 + h * 128 + (p_ & 15) * 8); \
            const int d_ = p_ >> 3; st[10 + j_] = *(const u32x4*)(pdn + (size_t)(R0_ + (d_ >> 1)) * 3072 + 1024 + h * 128 + (d_ & 1) * 64 + (p_ & 7) * 8); } \
        _Pragma("unroll") for (int j_ = 0; j_ < 2; ++j_) { const int p_ = lt + 256 * j_; st[8 + j_] = *(const u32x4*)(ext_ + 16384 + (size_t)p_ * 16); } \
        if (lt < 20) stdk = *(const u32x4*)((const float*)(P.ws + WS_SC_DN) + (size_t)(gch_ * 8 + h) * 80 + lt * 4); } while (0)
#define SDN_STORE(bb, st, stdk) do { LAS unsigned char* B_ = lds + (bb) * SC_BUF; \
        _Pragma("unroll") for (int j_ = 0; j_ < 4; ++j_) { const int p_ = lt + 256 * j_; *(LAS u32x4*)(B_ + SC_WN + (p_ >> 4) * 272 + (p_ & 15) * 16) = st[j_]; *(LAS u32x4*)(B_ + SC_QD + (p_ >> 4) * 272 + (p_ & 15) * 16) = st[4 + j_]; \
            *(LAS u32x4*)(B_ + SC_KT + (p_ >> 3) * 144 + (p_ & 7) * 16) = st[10 + j_]; } \
        _Pragma("unroll") for (int j_ = 0; j_ < 2; ++j_) { const int p_ = lt + 256 * j_; *(LAS u32x4*)(B_ + SC_QK + (p_ >> 3) * 144 + (p_ & 7) * 16) = st[8 + j_]; } \
        if (lt < 20) *(LAS u32x4*)(lds + SC_DK + (bb) * 512 + lt * 16) = stdk; } while (0)
#define SDN_ULOAD(cc) do { const int R0_ = (b * NCH + (cc)) * 64; const int e_ = e0 + r; \
        _Pragma("unroll") for (int q_ = 0; q_ < 8; ++q_) su[q_] = *(const u32x2*)(pdn + (size_t)(R0_ + (e_ >> 1)) * 3072 + 2048 + h * 128 + (e_ & 1) * 64 + 32 * (q_ >> 2) + 8 * (q_ & 3) + 4 * hh); } while (0)
    if (!comp) {
        u32x4 sa[14], sb[14], sc[14]; u32x4 da, db, dc;
        SDN_LOAD(0, sa, da); SDN_STORE(0, sa, da);
        SDN_LOAD(1, sb, db); SDN_LOAD(2, sc, dc);
        SBAR();
#define SDN_STEP(i, SL, DL, SS, DS) do { const int bb_ = (i) & 1; const int R0_s = (b * NCH + (i)) * 64; \
            if ((i) > 0 && lt < 64) { const LAS float* sp = (const LAS float*)(lds + SC_SSQ + (bb_ ^ 1) * 2048); ssqg[(size_t)(R0_s - 64 + lt) * 8 + h] = (sp[lt] + sp[64 + lt]) + (sp[128 + lt] + sp[192 + lt]); } \
            if ((i) + 3 < NCH) SDN_LOAD((i) + 3, SL, DL); \
            if ((i) + 1 < NCH) SDN_STORE(bb_ ^ 1, SS, DS); \
            SBAR(); } while (0)
        for (int c3 = 0; c3 < NCH; c3 += 3) { SDN_STEP(c3, sa, da, sb, db); SDN_STEP(c3 + 1, sb, db, sc, dc); SDN_STEP(c3 + 2, sc, dc, sa, da); }
#undef SDN_STEP
        if (lt < 64) { const LAS float* sp = (const LAS float*)(lds + SC_SSQ + ((NCH - 1) & 1) * 2048); ssqg[(size_t)((b * NCH + NCH - 1) * 64 + lt) * 8 + h] = (sp[lt] + sp[64 + lt]) + (sp[128 + lt] + sp[192 + lt]); }
        SBAR();
    } else {
        f32x16 S[4];
#pragma unroll
        for (int i = 0; i < 4; ++i)
#pragma unroll
            for (int e = 0; e < 16; ++e) S[i][e] = 0.f;
        u32x2 su[8], ucur[8], unx[8];
        SDN_ULOAD(0);
#pragma unroll
        for (int q = 0; q < 8; ++q) ucur[q] = su[q];
        SDN_ULOAD(1);
#pragma unroll
        for (int q = 0; q < 8; ++q) unx[q] = su[q];
        SBAR();
        for (int c = 0; c < NCH; ++c) {
            const int bb = c & 1; const LAS unsigned char* B = lds + bb * SC_BUF; const LAS float* DK = (const LAS float*)(lds + SC_DK + bb * 512);
            const int R0 = (b * NCH + c) * 64;
            if (c + 2 < NCH) SDN_ULOAD(c + 2);
            f32x16 vn[2], oT[2];
#pragma unroll
            for (int mi = 0; mi < 2; ++mi)
#pragma unroll
                for (int g4 = 0; g4 < 4; ++g4) { const u32x2 u = ucur[4 * mi + g4]; vn[mi][4 * g4] = bflo(u.x); vn[mi][4 * g4 + 1] = bfhi(u.x); vn[mi][4 * g4 + 2] = bflo(u.y); vn[mi][4 * g4 + 3] = bfhi(u.y);
                    oT[mi][4 * g4] = 0.f; oT[mi][4 * g4 + 1] = 0.f; oT[mi][4 * g4 + 2] = 0.f; oT[mi][4 * g4 + 3] = 0.f; }
            bf16x8 fw[2][2], fq[2][2];
#pragma unroll
            for (int mi = 0; mi < 2; ++mi) { fw[0][mi] = frag32(B + SC_WN, 272, 32 * mi + r, 0, hh); fq[0][mi] = frag32(B + SC_QD, 272, 32 * mi + r, 0, hh); }
#pragma unroll
            for (int s = 0; s < 8; ++s) { const int cu = s & 1, nx = cu ^ 1;
                if (s < 7) {
#pragma unroll
                    for (int mi = 0; mi < 2; ++mi) { fw[nx][mi] = frag32(B + SC_WN, 272, 32 * mi + r, 16 * (s + 1), hh); fq[nx][mi] = frag32(B + SC_QD, 272, 32 * mi + r, 16 * (s + 1), hh); } }
                const bf16x8 Sf = packacc8(S[s >> 1], s & 1);
                __builtin_amdgcn_sched_barrier(0);
#pragma unroll
                for (int mi = 0; mi < 2; ++mi) { vn[mi] = MFMA32(fw[cu][mi], Sf, vn[mi]); oT[mi] = MFMA32(Sf, fq[cu][mi], oT[mi]); }
                __builtin_amdgcn_sched_barrier(0); }
            bf16x8 fk[4][2];
#pragma unroll
            for (int t = 0; t < 4; ++t)
#pragma unroll
                for (int ni = 0; ni < 2; ++ni) fk[t][ni] = frag32(B + SC_QK, 144, 32 * ni + r, 16 * t, hh);
            bf16x8 vb[4], vd[4];
#pragma unroll
            for (int t = 0; t < 4; ++t) { const int mi = t >> 1, h2 = t & 1; vb[t] = packacc8(vn[mi], h2);
                const f32x4 d0 = *(const LAS f32x4*)(DK + 32 * mi + 16 * h2 + 4 * hh), d1 = *(const LAS f32x4*)(DK + 32 * mi + 16 * h2 + 8 + 4 * hh);
                u32x4 w; w.x = pk2(vn[mi][8 * h2] * d0[0], vn[mi][8 * h2 + 1] * d0[1]); w.y = pk2(vn[mi][8 * h2 + 2] * d0[2], vn[mi][8 * h2 + 3] * d0[3]);
                w.z = pk2(vn[mi][8 * h2 + 4] * d1[0], vn[mi][8 * h2 + 5] * d1[1]); w.w = pk2(vn[mi][8 * h2 + 6] * d1[2], vn[mi][8 * h2 + 7] * d1[3]); vd[t] = __builtin_bit_cast(bf16x8, w); }
            const float egl = DK[64];
            bf16x8 ft[2][4];
#pragma unroll
            for (int t = 0; t < 4; ++t) ft[0][t] = frag32(B + SC_KT, 144, r, 16 * t, hh);
            __builtin_amdgcn_sched_barrier(0);
#pragma unroll
            for (int t = 0; t < 4; ++t)
#pragma unroll
                for (int ni = 0; ni < 2; ++ni) oT[ni] = MFMA32(vb[t], fk[t][ni], oT[ni]);
            __builtin_amdgcn_sched_barrier(0);
#pragma unroll
            for (int db = 0; db < 4; ++db) { const int cu = db & 1, nx = cu ^ 1;
                if (db < 3) {
#pragma unroll
                    for (int t = 0; t < 4; ++t) ft[nx][t] = frag32(B + SC_KT, 144, 32 * (db + 1) + r, 16 * t, hh); }
                S[db] = S[db] * egl;
                __builtin_amdgcn_sched_barrier(0);
#pragma unroll
                for (int t = 0; t < 4; ++t) S[db] = MFMA32(ft[cu][t], vd[t], S[db]);
                __builtin_amdgcn_sched_barrier(0); }
            LAS float* sq = (LAS float*)(lds + SC_SSQ + bb * 2048);
#pragma unroll
            for (int ni = 0; ni < 2; ++ni) { float s = 0.f;
#pragma unroll
                for (int g4 = 0; g4 < 4; ++g4) { u32x2 w; w.x = pk2(oT[ni][4 * g4], oT[ni][4 * g4 + 1]); w.y = pk2(oT[ni][4 * g4 + 2], oT[ni][4 * g4 + 3]);
                    *(u32x2*)(pdn + (size_t)(R0 + 32 * ni + r) * 3072 + h * 128 + e0 + 8 * g4 + 4 * hh) = w;
                    s += (oT[ni][4 * g4] * oT[ni][4 * g4] + oT[ni][4 * g4 + 1] * oT[ni][4 * g4 + 1]) + (oT[ni][4 * g4 + 2] * oT[ni][4 * g4 + 2] + oT[ni][4 * g4 + 3] * oT[ni][4 * g4 + 3]); }
                s += __shfl_xor(s, 32);
                if (hh == 0) sq[wave * 64 + 32 * ni + r] = s; }
#pragma unroll
            for (int q = 0; q < 8; ++q) { ucur[q] = unx[q]; unx[q] = su[q]; }
            SBAR();
        }
        SBAR();
    }
#undef SDN_LOAD
#undef SDN_STORE
#undef SDN_ULOAD
}

constexpr int SG_QD = 0, SG_ATT = 17408, SG_KT = 26624, SG_V = 45056;
DI void scan_gla_item(const Params& P, LAS unsigned char* lds, int item) {
    int tid_o = threadIdx.x; asm volatile("" : "+v"(tid_o)); const int tid = tid_o, lane = tid & 63, wave = __builtin_amdgcn_readfirstlane(tid >> 6);
    const int half = item & 1, h = (item >> 1) & 3, b = item >> 3, r = lane & 31, hh = lane >> 5, e0 = 32 * (wave & 3);
    const bool comp = wave < 4; const int lt = tid - 256;
    bf16* pg = (bf16*)(P.ws + WS_PGLA); float* ssqg = (float*)(P.ws + WS_SSQ_GLA);
    const int vcol = 1024 + h * 256 + half * 128;
#define SGL_LOAD(cc, st, ste) do { const int gch_ = b * NCH + (cc); const int R0_ = gch_ * 64; const int it_ = gch_ * 4 + h; \
        _Pragma("unroll") for (int j_ = 0; j_ < 4; ++j_) { const int p_ = lt + 256 * j_; st[j_] = *(const u32x4*)(pg + (size_t)(R0_ + (p_ >> 4)) * 2048 + h * 128 + (p_ & 15) * 8); \
            const int d_ = p_ >> 3; st[4 + j_] = *(const u32x4*)(pg + (size_t)(R0_ + (d_ >> 1)) * 2048 + 512 + h * 128 + (d_ & 1) * 64 + (p_ & 7) * 8); \
            st[8 + j_] = *(const u32x4*)(pg + (size_t)(R0_ + (p_ >> 4)) * 2048 + vcol + (p_ & 15) * 8); } \
        _Pragma("unroll") for (int j_ = 0; j_ < 2; ++j_) { const int p_ = lt + 256 * j_; st[12 + j_] = *(const u32x4*)(P.ws + WS_ATT + (size_t)it_ * 8192 + (size_t)p_ * 16); } \
        if (lt < 32) ste = *(const u32x4*)((const float*)(P.ws + WS_EBL) + (size_t)it_ * 128 + lt * 4); } while (0)
#define SGL_STORE(bb, st, ste) do { LAS unsigned char* B_ = lds + (bb) * SC_BUF; \
        _Pragma("unroll") for (int j_ = 0; j_ < 4; ++j_) { const int p_ = lt + 256 * j_; *(LAS u32x4*)(B_ + SG_QD + (p_ >> 4) * 272 + (p_ & 15) * 16) = st[j_]; \
            *(LAS u32x4*)(B_ + SG_KT + (p_ >> 3) * 144 + (p_ & 7) * 16) = st[4 + j_]; *(LAS u32x4*)(B_ + SG_V + (p_ >> 4) * 272 + (p_ & 15) * 16) = st[8 + j_]; } \
        _Pragma("unroll") for (int j_ = 0; j_ < 2; ++j_) { const int p_ = lt + 256 * j_; *(LAS u32x4*)(B_ + SG_ATT + (p_ >> 3) * 144 + (p_ & 7) * 16) = st[12 + j_]; } \
        if (lt < 32) *(LAS u32x4*)(lds + SC_DK + (bb) * 512 + lt * 16) = ste; } while (0)
    if (!comp) {
        u32x4 sa[14], sb[14], sc[14]; u32x4 da, db, dc;
        SGL_LOAD(0, sa, da); SGL_STORE(0, sa, da);
        SGL_LOAD(1, sb, db); SGL_LOAD(2, sc, dc);
        SBAR();
#define SGL_STEP(i, SL, DL, SS, DS) do { const int bb_ = (i) & 1; const int R0_s = (b * NCH + (i)) * 64; \
            if ((i) > 0 && lt < 64) { const LAS float* sp = (const LAS float*)(lds + SC_SSQ + (bb_ ^ 1) * 2048); ssqg[(size_t)(R0_s - 64 + lt) * 8 + h * 2 + half] = (sp[lt] + sp[64 + lt]) + (sp[128 + lt] + sp[192 + lt]); } \
            if ((i) + 3 < NCH) SGL_LOAD((i) + 3, SL, DL); \
            if ((i) + 1 < NCH) SGL_STORE(bb_ ^ 1, SS, DS); \
            SBAR(); } while (0)
        for (int c3 = 0; c3 < NCH; c3 += 3) { SGL_STEP(c3, sa, da, sb, db); SGL_STEP(c3 + 1, sb, db, sc, dc); SGL_STEP(c3 + 2, sc, dc, sa, da); }
#undef SGL_STEP
        if (lt < 64) { const LAS float* sp = (const LAS float*)(lds + SC_SSQ + ((NCH - 1) & 1) * 2048); ssqg[(size_t)((b * NCH + NCH - 1) * 64 + lt) * 8 + h * 2 + half] = (sp[lt] + sp[64 + lt]) + (sp[128 + lt] + sp[192 + lt]); }
        SBAR();
    } else {
        f32x16 S[4];
#pragma unroll
        for (int i = 0; i < 4; ++i)
#pragma unroll
            for (int e = 0; e < 16; ++e) S[i][e] = 0.f;
        SBAR();
        for (int c = 0; c < NCH; ++c) {
            const int bb = c & 1; const LAS unsigned char* B = lds + bb * SC_BUF; const LAS float* EB = (const LAS float*)(lds + SC_DK + bb * 512);
            const int R0 = (b * NCH + c) * 64;
            f32x16 oT[2];
#pragma unroll
            for (int ni = 0; ni < 2; ++ni)
#pragma unroll
                for (int e = 0; e < 16; ++e) oT[ni][e] = 0.f;
            bf16x8 fq[2][2];
#pragma unroll
            for (int ni = 0; ni < 2; ++ni) fq[0][ni] = frag32(B + SG_QD, 272, 32 * ni + r, 0, hh);
            bf16x8 vf[4], fk[4][2];
#pragma unroll
            for (int t = 0; t < 4; ++t) { const LAS bf16* vp = (const LAS bf16*)(B + SG_V) + (16 * t + 4 * hh) * 136 + e0 + r; u32x4 w;
                w.x = (unsigned)vp[0] | ((unsigned)vp[136] << 16); w.y = (unsigned)vp[2 * 136] | ((unsigned)vp[3 * 136] << 16);
                w.z = (unsigned)vp[8 * 136] | ((unsigned)vp[9 * 136] << 16); w.w = (unsigned)vp[10 * 136] | ((unsigned)vp[11 * 136] << 16);
                vf[t] = __builtin_bit_cast(bf16x8, w); }
#pragma unroll
            for (int s = 0; s < 8; ++s) { const int cu = s & 1, nx = cu ^ 1;
                if (s < 7) {
#pragma unroll
                    for (int ni = 0; ni < 2; ++ni) fq[nx][ni] = frag32(B + SG_QD, 272, 32 * ni + r, 16 * (s + 1), hh); }
                const bf16x8 Sf = packacc8(S[s >> 1], s & 1);
                __builtin_amdgcn_sched_barrier(0);
#pragma unroll
                for (int ni = 0; ni < 2; ++ni) oT[ni] = MFMA32(Sf, fq[cu][ni], oT[ni]);
                __builtin_amdgcn_sched_barrier(0); }
#pragma unroll
            for (int t = 0; t < 4; ++t)
#pragma unroll
                for (int ni = 0; ni < 2; ++ni) fk[t][ni] = frag32(B + SG_ATT, 144, 32 * ni + r, 16 * t, hh);
            bf16x8 ft[2][4];
#pragma unroll
            for (int t = 0; t < 4; ++t) ft[0][t] = frag32(B + SG_KT, 144, r, 16 * t, hh);
            __builtin_amdgcn_sched_barrier(0);
#pragma unroll
            for (int t = 0; t < 4; ++t)
#pragma unroll
                for (int ni = 0; ni < 2; ++ni) oT[ni] = MFMA32(vf[t], fk[t][ni], oT[ni]);
            __builtin_amdgcn_sched_barrier(0);
#pragma unroll
            for (int db = 0; db < 4; ++db) { const int cu = db & 1, nx = cu ^ 1;
                if (db < 3) {
#pragma unroll
                    for (int t = 0; t < 4; ++t) ft[nx][t] = frag32(B + SG_KT, 144, 32 * (db + 1) + r, 16 * t, hh); }
                __builtin_amdgcn_sched_barrier(0);
#pragma unroll
                for (int t = 0; t < 4; ++t) S[db] = MFMA32(ft[cu][t], vf[t], S[db]);
                __builtin_amdgcn_sched_barrier(0);
#pragma unroll
                for (int g4 = 0; g4 < 4; ++g4) { const f32x4 eb = *(const LAS f32x4*)(EB + 32 * db + 8 * g4 + 4 * hh);
                    S[db][4 * g4] *= eb[0]; S[db][4 * g4 + 1] *= eb[1]; S[db][4 * g4 + 2] *= eb[2]; S[db][4 * g4 + 3] *= eb[3]; } }
            LAS float* sq = (LAS float*)(lds + SC_SSQ + bb * 2048);
#pragma unroll
            for (int ni = 0; ni < 2; ++ni) { float s = 0.f;
#pragma unroll
                for (int g4 = 0; g4 < 4; ++g4) { u32x2 w; w.x = pk2(oT[ni][4 * g4], oT[ni][4 * g4 + 1]); w.y = pk2(oT[ni][4 * g4 + 2], oT[ni][4 * g4 + 3]);
                    *(u32x2*)(pg + (size_t)(R0 + 32 * ni + r) * 2048 + vcol + e0 + 8 * g4 + 4 * hh) = w;
                    s += (oT[ni][4 * g4] * oT[ni][4 * g4] + oT[ni][4 * g4 + 1] * oT[ni][4 * g4 + 1]) + (oT[ni][4 * g4 + 2] * oT[ni][4 * g4 + 2] + oT[ni][4 * g4 + 3] * oT[ni][4 * g4 + 3]); }
                s += __shfl_xor(s, 32);
                if (hh == 0) sq[wave * 64 + 32 * ni + r] = s; }
            SBAR();
        }
        SBAR();
    }
#undef SGL_LOAD
#undef SGL_STORE
}

constexpr int RT_WR = 0, RT_WBUF = 43520, RT_LG = 87040, RT_RS = 128000, RT_HS = 128512;
DI void router_group(const Params& P, LAS unsigned char* lds, int rg) {
    int tid_o = threadIdx.x; asm volatile("" : "+v"(tid_o)); const int tid = tid_o, lane = tid & 63, wave = __builtin_amdgcn_readfirstlane(tid >> 6);
    const unsigned char* wsrc = P.ws + WS_WRT; unsigned char* xb8 = P.ws + WS_XB;
    LAS float* LG = (LAS float*)(lds + RT_LG); LAS float* RS = (LAS float*)(lds + RT_RS); LAS int* HS = (LAS int*)(lds + RT_HS);
    const int i = lane & 15, kq = lane >> 4; const int row = rg * 128 + wave * 16 + i;
    const bf16* hhi = H1HI((const bf16*)(P.ws + WS_PGLA), row) + 8 * kq; const bf16* hlo = (const bf16*)P.out + (size_t)row * 1024 + 8 * kq;
    if (tid < 64) HS[tid] = 0;
    LAS float* BI = (LAS float*)(lds + RT_HS + 256);
    if (tid >= 64 && tid < 136) BI[tid - 64] = (tid < 72) ? P.in[16][tid - 64] : P.in[18][tid - 72];
    f32x4 acc[5];
#pragma unroll
    for (int cb = 0; cb < 5; ++cb) acc[cb] = (f32x4){0.f, 0.f, 0.f, 0.f};
    float ssq = 0.f;
    u32x4 wst[5]; u32x4 aA[8], aB[8];
    int soff[5], doff[5];
#pragma unroll
    for (int q = 0; q < 5; ++q) { const int p = tid + 512 * q, hl = p / 1280, rem = p - hl * 1280, n = rem >> 4, c16 = rem & 15; soff[q] = (hl * 80 + n) * 2048 + c16 * 16; doff[q] = (hl * 80 + n) * 272 + c16 * 16; }
#pragma unroll
    for (int q = 0; q < 5; ++q) wst[q] = *(const u32x4*)(wsrc + soff[q]);
#pragma unroll
    for (int t = 0; t < 8; ++t) aA[t] = *(const u32x4*)(((t & 1) ? hlo : hhi) + 32 * (t >> 1));
#pragma unroll
    for (int t = 0; t < 8; ++t) aB[t] = *(const u32x4*)(((t & 1) ? hlo : hhi) + 128 + 32 * (t >> 1));
#pragma unroll
    for (int q = 0; q < 5; ++q) *(LAS u32x4*)(lds + RT_WR + doff[q]) = wst[q];
#define RT_CHUNK(A_, kc_) { const int kc = (kc_); \
        asm volatile("s_waitcnt lgkmcnt(0)\n\ts_barrier" ::: "memory"); \
        const LAS unsigned char* WB = lds + RT_WR + (kc & 1) * RT_WBUF; \
        if (kc < 7) { _Pragma("unroll") for (int q = 0; q < 5; ++q) wst[q] = *(const u32x4*)(wsrc + soff[q] + (kc + 1) * 256); } \
        _Pragma("unroll") for (int s = 0; s < 4; ++s) { const u32x4 hw = A_[2 * s], lw = A_[2 * s + 1]; float hf[8], lf[8]; unpack8(hw, hf); unpack8(lw, lf); \
            if (kc + 2 < 8) { A_[2 * s] = *(const u32x4*)(hhi + (kc + 2) * 128 + 32 * s); A_[2 * s + 1] = *(const u32x4*)(hlo + (kc + 2) * 128 + 32 * s); } \
            const f32x4 x0 = {hf[0] + lf[0], hf[1] + lf[1], hf[2] + lf[2], hf[3] + lf[3]}, x1 = {hf[4] + lf[4], hf[5] + lf[5], hf[6] + lf[6], hf[7] + lf[7]}; \
            ssq += (x0[0] * x0[0] + x0[1] * x0[1]) + (x0[2] * x0[2] + x0[3] * x0[3]) + (x1[0] * x1[0] + x1[1] * x1[1]) + (x1[2] * x1[2] + x1[3] * x1[3]); \
            { u32x2 w8; w8.x = pk4_fp8(x0[0], x0[1], x0[2], x0[3]); w8.y = pk4_fp8(x1[0], x1[1], x1[2], x1[3]); *(u32x2*)(xb8 + (size_t)row * 1024 + kc * 128 + 32 * s + 8 * kq) = w8; } \
            const bf16x8 ah = __builtin_bit_cast(bf16x8, hw), al = __builtin_bit_cast(bf16x8, lw); \
            _Pragma("unroll") for (int cb = 0; cb < 5; ++cb) { const bf16x8 bh = *(const LAS bf16x8*)(WB + (16 * cb + i) * 272 + (32 * s + 8 * kq) * 2), bl = *(const LAS bf16x8*)(WB + (80 + 16 * cb + i) * 272 + (32 * s + 8 * kq) * 2); \
                acc[cb] = MFMA16(ah, bh, acc[cb]); acc[cb] = MFMA16(ah, bl, acc[cb]); acc[cb] = MFMA16(al, bh, acc[cb]); } } \
        if (kc < 7) { _Pragma("unroll") for (int q = 0; q < 5; ++q) *(LAS u32x4*)(lds + RT_WR + ((kc + 1) & 1) * RT_WBUF + doff[q]) = wst[q]; } }
#pragma nounroll
    for (int k2 = 0; k2 < 8; k2 += 2) { RT_CHUNK(aA, k2) RT_CHUNK(aB, k2 + 1) }
#undef RT_CHUNK
    ssq += __shfl_xor(ssq, 16); ssq += __shfl_xor(ssq, 32);
    if (kq == 0) RS[wave * 16 + i] = rsqrtf(ssq * (1.f / 1024.f) + EPS);
#pragma unroll
    for (int cb = 0; cb < 5; ++cb)
#pragma unroll
        for (int reg = 0; reg < 4; ++reg) LG[(wave * 16 + 4 * kq + reg) * 80 + 16 * cb + i] = acc[cb][reg];
    __syncthreads();
    if (tid < 128) {
        const int t = rg * 128 + tid; const float rs = RS[tid]; const LAS float* lg = LG + tid * 80;
        float gl[8]; int gs = 0; float gm = -3.4e38f;
#pragma unroll
        for (int j = 0; j < 8; ++j) { gl[j] = rs * lg[j] + BI[j]; if (gl[j] > gm) { gm = gl[j]; gs = j; } }
        float den = 0.f;
#pragma unroll
        for (int j = 0; j < 8; ++j) den += __expf(gl[j] - gm);
        const float gw = 1.f / den;
        float v1 = -3.4e38f, v2 = -3.4e38f; int i1 = 0, i2 = 0;
#pragma unroll
        for (int e = 0; e < 8; ++e) { const float v = rs * lg[16 + 8 * gs + e] + BI[8 + 8 * gs + e];
            if (v > v1) { v2 = v1; i2 = i1; v1 = v; i1 = e; } else if (v > v2) { v2 = v; i2 = e; } }
        const float p1 = 1.f / (1.f + __expf(v2 - v1));
        int* re = (int*)(P.ws + WS_ROUTE + RT_E); float* rgt = (float*)(P.ws + WS_ROUTE + RT_G); float* rr = (float*)(P.ws + WS_ROUTE + RT_RSTD);
        re[2 * t] = 8 * gs + i1; re[2 * t + 1] = 8 * gs + i2; rgt[2 * t] = p1 * gw; rgt[2 * t + 1] = (1.f - p1) * gw; rr[t] = rs;
        atomicAdd((int*)(lds + RT_HS) + 8 * gs + i1, 1); atomicAdd((int*)(lds + RT_HS) + 8 * gs + i2, 1);
    }
    __syncthreads();
    if (tid < 64) ((int*)(P.ws + WS_ROUTE + RT_HIST))[rg * 64 + tid] = HS[tid];
    __syncthreads();
}

DI void lists_phase(const Params& P, LAS unsigned char* lds, int rgA, int rgB) {
    int tid_o = threadIdx.x; asm volatile("" : "+v"(tid_o)); const int tid = tid_o;
    LAS int* TOT = (LAS int*)lds; LAS int* PREA = TOT + 64; LAS int* PREB = TOT + 128; LAS int* PST = TOT + 192; LAS int* EA = TOT + 320; LAS int* PART = TOT + 1024;
    const int* hist = (const int*)(P.ws + WS_ROUTE + RT_HIST);
    const int* re = (const int*)(P.ws + WS_ROUTE + RT_E); const float* rgt = (const float*)(P.ws + WS_ROUTE + RT_G); const float* rr = (const float*)(P.ws + WS_ROUTE + RT_RSTD);
    int* stok = (int*)(P.ws + WS_ROUTE + RT_STOK); int* stk = (int*)(P.ws + WS_ROUTE + RT_STK); float* sg = (float*)(P.ws + WS_ROUTE + RT_SGATE); float* srs = (float*)(P.ws + WS_ROUTE + RT_SRSTD);
    int* texp = (int*)(P.ws + WS_ROUTE + RT_TEXP);
    { const int e = tid & 63, part = tid >> 6; int tot = 0, pa = 0, pb = 0;
#pragma unroll 8
        for (int q = 0; q < 64; ++q) { const int r = part * 64 + q; const int v = hist[r * 64 + e]; tot += v; pa += (r < rgA) ? v : 0; pb += (r < rgB) ? v : 0; }
        PART[part * 64 + e] = tot; PART[512 + part * 64 + e] = pa; PART[1024 + part * 64 + e] = pb; }
    __syncthreads();
    if (tid < 64) { int tot = 0, pa = 0, pb = 0;
#pragma unroll
        for (int p = 0; p < 8; ++p) { tot += PART[p * 64 + tid]; pa += PART[512 + p * 64 + tid]; pb += PART[1024 + p * 64 + tid]; }
        TOT[tid] = tot; PREA[tid] = pa; PREB[tid] = pb; }
    __syncthreads();
    if (tid == 0) { int s = 0; for (int e = 0; e < 64; ++e) { PST[e] = s; s += (TOT[e] + 255) & ~255; } PST[64] = s; }
    __syncthreads();
    for (int pass = 0; pass < 2; ++pass) {
        const int rg = pass ? rgB : rgA; const LAS int* PRE = pass ? PREB : PREA;
        if (rg >= 0) {
            if (tid < 256) EA[tid] = re[rg * 256 + tid];
            __syncthreads();
            if (tid < 256) { const int e = EA[tid]; int rank = 0; for (int a = 0; a < tid; ++a) rank += (EA[a] == e) ? 1 : 0;
                const int slot = PST[e] + PRE[e] + rank, t = rg * 128 + (tid >> 1), k = tid & 1;
                stok[slot] = t; stk[slot] = t | (k << 16); sg[slot] = rgt[rg * 256 + tid]; srs[slot] = rr[t]; ((int*)(P.ws + WS_ROUTE + RT_TSLOT))[2 * t + k] = slot; }
            __syncthreads();
        }
    }
    if (blockIdx.x < 64) { const int e = blockIdx.x; for (int s = PST[e] + TOT[e] + tid; s < PST[e + 1]; s += NTHREADS) { stok[s] = 0; stk[s] = -1; sg[s] = 0.f; srs[s] = 0.f; } }
    if (blockIdx.x == 64) { for (int t = tid; t < MAXTILES; t += NTHREADS) { int e = -1; for (int q = 0; q < 64; ++q) if (PST[q] <= 256 * t && 256 * t < PST[q + 1]) e = q; texp[t] = e; }
        if (tid == 0) texp[MAXTILES] = PST[64] >> 8; }
    __syncthreads();
}

DI void phase_final(const Params& P, bool with_moe) {
    int tid_o = threadIdx.x; asm volatile("" : "+v"(tid_o)); const int tid = tid_o, lane = tid & 63, wave = __builtin_amdgcn_readfirstlane(tid >> 6); const int gw = blockIdx.x * 8 + wave, NGW = gridDim.x * 8;
    const unsigned char* Y = P.ws + WS_Y; const float* g = P.in[22]; const int* tslot = (const int*)(P.ws + WS_ROUTE + RT_TSLOT);
    const bf16* hbase = (const bf16*)(P.ws + WS_PGLA);
    f32x4 gv[4];
#pragma unroll
    for (int j = 0; j < 4; ++j) gv[j] = ((const f32x4*)g)[lane + 64 * j];
    u32x2 hn[4]; int yan[4], ybn[4]; int s0n = 0, s1n = 0;
    int t = gw;
    if (t < TR) { const int s0 = with_moe ? tslot[2 * t] : 0, s1 = with_moe ? tslot[2 * t + 1] : 0;
        const u32x2* hh = (const u32x2*)H1HI(hbase, t) + lane; const int* ya = (const int*)(Y + (size_t)s0 * 1024) + lane; const int* yb = (const int*)(Y + (size_t)s1 * 1024) + lane;
#pragma unroll
        for (int j = 0; j < 4; ++j) { hn[j] = hh[64 * j]; yan[j] = ya[64 * j]; ybn[j] = yb[64 * j]; }
        if (t + NGW < TR && with_moe) { s0n = tslot[2 * (t + NGW)]; s1n = tslot[2 * (t + NGW) + 1]; } }
#pragma nounroll
    for (; t < TR; t += NGW) {
        u32x2 hc[4]; int yac[4], ybc[4];
#pragma unroll
        for (int j = 0; j < 4; ++j) { hc[j] = hn[j]; yac[j] = yan[j]; ybc[j] = ybn[j]; }
        const int tn = t + NGW;
        if (tn < TR) { const u32x2* hh = (const u32x2*)H1HI(hbase, tn) + lane; const int* ya = (const int*)(Y + (size_t)s0n * 1024) + lane; const int* yb = (const int*)(Y + (size_t)s1n * 1024) + lane;
#pragma unroll
            for (int j = 0; j < 4; ++j) { hn[j] = hh[64 * j]; yan[j] = ya[64 * j]; ybn[j] = yb[64 * j]; }
            if (tn + NGW < TR && with_moe) { s0n = tslot[2 * (tn + NGW)]; s1n = tslot[2 * (tn + NGW) + 1]; } }
        f32x4 v[4]; float s = 0.f;
#pragma unroll
        for (int j = 0; j < 4; ++j) { v[j] = (f32x4){bflo(hc[j].x), bfhi(hc[j].x), bflo(hc[j].y), bfhi(hc[j].y)};
            if (with_moe) { const int y0 = yac[j], y1 = ybc[j];
                v[j][0] += (__builtin_amdgcn_cvt_f32_fp8(y0, 0) + __builtin_amdgcn_cvt_f32_fp8(y1, 0)) * 0.125f; v[j][1] += (__builtin_amdgcn_cvt_f32_fp8(y0, 1) + __builtin_amdgcn_cvt_f32_fp8(y1, 1)) * 0.125f;
                v[j][2] += (__builtin_amdgcn_cvt_f32_fp8(y0, 2) + __builtin_amdgcn_cvt_f32_fp8(y1, 2)) * 0.125f; v[j][3] += (__builtin_amdgcn_cvt_f32_fp8(y0, 3) + __builtin_amdgcn_cvt_f32_fp8(y1, 3)) * 0.125f; }
            s += (v[j][0] * v[j][0] + v[j][1] * v[j][1]) + (v[j][2] * v[j][2] + v[j][3] * v[j][3]); }
        const float rs = rsqrtf(wave_sum(s) * (1.f / 1024.f) + EPS);
        f32x4* hr = (f32x4*)(P.out + (size_t)t * 1024) + lane;
#pragma unroll
        for (int j = 0; j < 4; ++j) hr[64 * j] = v[j] * rs * gv[j];
    }
}


#define XB_TMO      128
#define XB_XCNT(j)  (256  + 64 * (j))
#define XB_XSUB(j)  (1280 + 64 * (j))
#define XB_XGEN(j)  (2304 + 64 * (j))
#define XB_TOP      3328
#define XB_TOPGEN   3392
#define XCD_BAR_WORDS 3456
#define XB_SPIN_CAP (1u << 22)
DI unsigned xb_ld(unsigned* p)              { return __hip_atomic_load(p, __ATOMIC_RELAXED, __HIP_MEMORY_SCOPE_AGENT); }
DI unsigned xb_add(unsigned* p, unsigned v) { return __hip_atomic_fetch_add(p, v, __ATOMIC_RELAXED, __HIP_MEMORY_SCOPE_AGENT); }
DI unsigned xb_xcc_id() { return (unsigned)__builtin_amdgcn_s_getreg((3 << 11) | 20) & 0xFu; }
#define XB_SPIN(cond, bar) do { unsigned _sp = 0; while (cond) { __builtin_amdgcn_s_sleep(1); \
    if ((++_sp & 255u) == 0u) { if (xb_ld(&(bar)[XB_TMO])) break; if (_sp > XB_SPIN_CAP) { atomicAdd(&(bar)[XB_TMO], 1u); break; } } } } while (0)
struct XcdBarrier { unsigned* bar; unsigned x; volatile LAS unsigned* st; };
DI XcdBarrier xcd_barrier_post(unsigned* bar, volatile LAS unsigned* st) {
    XcdBarrier b; b.bar = bar; b.x = xb_xcc_id(); b.st = st;
    if (threadIdx.x == 0) (void)xb_add(&bar[XB_XCNT(b.x)], 1u);
    return b;
}
DI void xcd_barrier_complete(unsigned* bar, unsigned x, unsigned& nloc, unsigned& nx) {
    const unsigned G = gridDim.x * gridDim.y * gridDim.z;
    unsigned sum, cnt, mine, sp = 0u;
    for (;;) {
        sum = 0u; cnt = 0u; mine = 0u;
#pragma unroll
        for (unsigned j = 0; j < 16; ++j) { const unsigned c = xb_ld(&bar[XB_XCNT(j)]); sum += c; cnt += (c > 0u) ? 1u : 0u; mine = (j == x) ? c : mine; }
        if (sum == G) break;
        __builtin_amdgcn_s_sleep(1);
        if ((++sp & 255u) == 0u) { if (xb_ld(&bar[XB_TMO])) break; if (sp > XB_SPIN_CAP) { atomicAdd(&bar[XB_TMO], 1u); break; } }
    }
    nloc = mine > 0u ? mine : 1u; nx = cnt > 0u ? cnt : 1u;
}
DI void xcd_barrier(const XcdBarrier& b) {
    asm volatile("s_waitcnt vmcnt(0)" ::: "memory");
    __syncthreads();
    if (threadIdx.x == 0) {
        unsigned* bar = b.bar;
        __builtin_amdgcn_s_waitcnt(0);
        unsigned nloc = b.st[0], nx = b.st[1];
        if (nloc == 0u) { xcd_barrier_complete(bar, b.x, nloc, nx); b.st[0] = nloc; b.st[1] = nx; }
        const unsigned old = xb_add(&bar[XB_XSUB(b.x)], 1u);
        const unsigned gen = old / nloc;
        if (old + 1u == (gen + 1u) * nloc) {
            __builtin_amdgcn_fence(__ATOMIC_RELEASE, "agent");
            asm volatile("s_waitcnt vmcnt(0)" ::: "memory");
            const unsigned og = xb_add(&bar[XB_TOP], 1u);
            const unsigned tg = og / nx;
            if (og + 1u == (tg + 1u) * nx) xb_add(&bar[XB_TOPGEN], 1u);
            else XB_SPIN(xb_ld(&bar[XB_TOPGEN]) == tg, bar);
            __builtin_amdgcn_fence(__ATOMIC_ACQUIRE, "agent");
            xb_add(&bar[XB_XGEN(b.x)], 1u);
            asm volatile("s_waitcnt vmcnt(0)" ::: "memory");
        } else {
            XB_SPIN(xb_ld(&bar[XB_XGEN(b.x)]) == gen, bar);
            __builtin_amdgcn_fence(__ATOMIC_ACQUIRE, "agent");
            asm volatile("s_waitcnt vmcnt(0)" ::: "memory");
        }
    }
    __syncthreads();
}

#ifndef MOE_ENABLED
#define MOE_ENABLED 1
#endif
constexpr int NPH = 13;
__global__ void __launch_bounds__(NTHREADS, 2) mega(Params P) {
    extern __shared__ __attribute__((aligned(16))) unsigned char lds_raw[];
    LAS unsigned char* lds = (LAS unsigned char*)lds_raw;
    cg::grid_group grid = cg::this_grid();
    volatile LAS unsigned* MISC = (volatile LAS unsigned*)(lds + LDS_BYTES - 64);
    if (threadIdx.x < 16) MISC[threadIdx.x] = 0u;
    __syncthreads();
    const XcdBarrier xbar = xcd_barrier_post((unsigned*)(P.ws + WS_CTL + 65536), MISC);
    const int G = gridDim.x, c = blockIdx.x;
#define KWS (P.ws)
#define KXN ((bf16*)P.out)
#define KPDN ((bf16*)(P.ws + WS_PDN))
#define KPGLA ((bf16*)(P.ws + WS_PGLA))
#define RUN_0 { phase_p0(P, lds); }
#define RUN_1 { MapPlain mp{(const char*)KXN, (const char*)(KWS + WS_W1T), (size_t)256 * 1024 * 2, (size_t)256 * 1024 * 2}; DenseOrder<MapPlain> S; S.init(TP / 256, N1 / 256, G, c, mp); \
        EpiProj E{KPDN, KPGLA, (bf16*)(KWS + WS_HALO), (float*)(KWS + WS_SMALL)}; \
        pg8::gemm_phase<EpiProj, DenseOrder<MapPlain>, false>(lds, 1024, 1024, S, E); }
#define RUN_2 { __syncthreads(); prep_dn_phase(P, lds); __syncthreads(); prep_gla_phase(P, lds); }
#define RUN_3 { __syncthreads(); for (int it = c; it < BATCH * 8; it += G) scan_dn_item(P, lds, it); for (int it = c; it < BATCH * 8; it += G) scan_gla_item(P, lds, it); }
#define RUN_4 { __syncthreads(); \
        phase_px(P, lds, G == 256); __syncthreads(); \
        MapReal mp{(const char*)KXN, (const char*)(KWS + WS_WZR), (size_t)2048, (size_t)256 * 1024 * 2}; SplitOrder<MapReal> S; S.init(256, 8, G, c, mp, 6, 4); \
        EpiZR E{KPDN, KPGLA, (const float*)(KWS + WS_SSQ_DN), (const float*)(KWS + WS_SSQ_GLA), P.in[7], P.in[11], KWS + WS_OG8}; \
        pg8::gemm_phase<EpiZR, SplitOrder<MapReal>, false>(lds, 1024, 1024, S, E); }
#define RUN_5 { \
        { MapReal mp{(const char*)KPDN, (const char*)(KWS + WS_WPDN), (size_t)3072 * 2, (size_t)256 * 1024 * 2}; DenseOrder<MapReal> S; S.init(256, 4, G, c, mp); \
            EpiStoreReal E{KPDN + 1024, 3072, 1.f}; pg8::gemm_phase<EpiStoreReal, DenseOrder<MapReal>, false>(lds, 1024, 3072, S, E); } \
        { MapPlain mp{(const char*)(KWS + WS_OG8), (const char*)(KWS + WS_WPGLA), (size_t)256 * 1024, (size_t)256 * 1024}; DenseOrder<MapPlain> S; S.init(256, 4, G, c, mp); \
            EpiStoreReal8 E{(unsigned char*)(KPDN + 2048), 6144, 8.f / 32.f}; pg8::gemm_phase<EpiStoreReal8, DenseOrder<MapPlain>, false, true>(lds, 512, 512, S, E); } }
#define RUN_6 { MapReal mp{(const char*)P.out + XN8_OFF, (const char*)(KWS + WS_WG), (size_t)1024, (size_t)256 * 1024}; DenseOrder<MapReal> S; S.init(256, 8, G, c, mp); \
        EpiMerge E{KPDN + 1024, (const unsigned char*)(KPDN + 2048), KPGLA}; pg8::gemm_phase<EpiMerge, DenseOrder<MapReal>, false, true>(lds, 512, 512, S, E); }
#define RUN_7 { MapReal mp{(const char*)KPGLA, (const char*)(KWS + WS_WOUT), (size_t)2048 * 2, (size_t)256 * 1024 * 2}; DenseOrder<MapReal> S; S.init(256, 4, G, c, mp); \
        EpiOut E{P.in[0], (bf16*)P.out, (bf16*)(P.ws + WS_PGLA)}; pg8::gemm_phase<EpiOut, DenseOrder<MapReal>, false>(lds, 1024, 2048, S, E); }
#define RUN_8 { __syncthreads(); for (int rg = c; rg < 512; rg += G) router_group(P, lds, rg); }
#define RUN_9 { __syncthreads(); lists_phase(P, lds, c < 512 ? c : -1, c + G < 512 ? c + G : -1); }
#define RUN_10 { __syncthreads(); const int* texp = (const int*)(KWS + WS_ROUTE + RT_TEXP); \
        ExpertOrder S{texp[MAXTILES], G, c, texp, (const int*)(KWS + WS_ROUTE + RT_STOK), (const char*)(KWS + WS_XB), (const char*)(KWS + WS_WEXP13), (size_t)0, (size_t)1024 * 1024, (size_t)256 * 1024}; \
        EpiE1 E{(const float*)(KWS + WS_ROUTE + RT_SRSTD), KWS + WS_H}; pg8::gemm_phase<EpiE1, ExpertOrder, true, true>(lds, 512, 512, S, E); }
#define RUN_11 { const int* texp = (const int*)(KWS + WS_ROUTE + RT_TEXP); \
        ExpertOrder S{texp[MAXTILES], G, c, texp, (const int*)(KWS + WS_ROUTE + RT_STOK), (const char*)(KWS + WS_H), (const char*)(KWS + WS_WEXP2), (size_t)256 * 512, (size_t)1024 * 512, (size_t)256 * 512}; \
        EpiE2 E{(const float*)(KWS + WS_ROUTE + RT_SGATE), KWS + WS_Y}; pg8::gemm_phase<EpiE2, ExpertOrder, false, true>(lds, 256, 256, S, E); }
#define RUN_12 { phase_final(P, MOE_ENABLED != 0); }
#define SY xcd_barrier(xbar);
#define SY0 grid.sync();
#ifndef PROGRAM
#define PROGRAM RUN_0 SY0 RUN_1 SY RUN_2 SY RUN_3 SY RUN_4 SY RUN_5 SY RUN_6 SY RUN_7 SY RUN_8 SY RUN_9 SY RUN_10 SY RUN_11 SY RUN_12
#endif
    PROGRAM
}

extern "C" void kernel_launch(void* const* d_in, const int* in_sizes, int n_in, void* d_out, int out_size, void* d_ws, size_t ws_size, hipStream_t stream) {
    static int grid = 0;
    if (grid == 0) {
        if (n_in != 23 || out_size != TR * 1024 || ws_size < WS_END) { fprintf(stderr, "kernel_launch: unexpected problem (n_in %d out %d ws %zu)\n", n_in, out_size, ws_size); grid = -1; return; }
        if (hipFuncSetAttribute((const void*)mega, hipFuncAttributeMaxDynamicSharedMemorySize, LDS_BYTES) != hipSuccess) { fprintf(stderr, "kernel_launch: hipFuncSetAttribute failed\n"); grid = -1; return; }
        int dev = 0, cus = 0, per_cu = 0; (void)hipGetDevice(&dev); (void)hipDeviceGetAttribute(&cus, hipDeviceAttributeMultiprocessorCount, dev);
        (void)hipOccupancyMaxActiveBlocksPerMultiprocessor(&per_cu, (const void*)mega, NTHREADS, LDS_BYTES);
        (void)hipGetLastError();
        if (per_cu < 1) { fprintf(stderr, "kernel_launch: occupancy query says %d blocks/CU\n", per_cu); }
        grid = cus;
        if (grid != 256) fprintf(stderr, "kernel_launch: note: %d CUs\n", grid);
    }
    if (grid < 0) return;
    Params p; memset(&p, 0, sizeof(p));
    for (int i = 0; i < 23; ++i) p.in[i] = (const float*)d_in[i];
    p.out = (float*)d_out; p.ws = (unsigned char*)d_ws;
    if (hipMemsetAsync((char*)d_ws + WS_CTL, 0, 1 << 20, stream) != hipSuccess) { fprintf(stderr, "memset failed\n"); return; }
    void* args[] = {&p};
    hipError_t e = hipLaunchCooperativeKernel((const void*)mega, dim3(grid), dim3(NTHREADS), args, LDS_BYTES, stream);
    if (e != hipSuccess) fprintf(stderr, "cooperative launch failed: %s\n", hipGetErrorString(e));
}
```
